# Optimizing an MI355X kernel written in HIP

```python
import jax, jax.numpy as jnp
from jax import lax
import numpy as np

D_MODEL = 1024
BATCH = 4
SEQ = 8192
DEPTH = 2

GRID_W = 64
CTX_LEN = 256
N_EVEN = (DEPTH + 1) // 2
N_ODD = DEPTH // 2
LRU_W = D_MODEL // 2
LRU_HEADS = 8
LRU_HD = LRU_W // LRU_HEADS
LRU_C = 8.0
CONV_W = 4
CONV_LEFT = 2
FFT_W = D_MODEL - LRU_W
FFT_GROUPS = 8
FFT_GD = FFT_W // FFT_GROUPS
AB_IN = 2 * LRU_W + FFT_W
NA_HEADS = 16
NA_HD = D_MODEL // NA_HEADS
NA_KH = 8
NA_KW = 16
FFN_HIDDEN = -(-8 * D_MODEL // (3 * 256)) * 256
EPS = 1e-6

kernel_name = 'hybrid_rglru_fnet_natten_dit_block'


def _rmsnorm(x, g):
    xf = x.astype(jnp.float32)
    y = xf * lax.rsqrt(jnp.mean(xf * xf, axis=-1, keepdims=True) + EPS) * g.astype(jnp.float32)
    return y.astype(x.dtype)


def _modulate(x, g, shift, scale):
    return _rmsnorm(x, g) * (1 + scale) + shift


def _swiglu(h, wg, wu, wd):
    return (jax.nn.silu(h @ wg) * (h @ wu)) @ wd


def _dwconv(u, w, b):
    T = u.shape[1]
    up = jnp.pad(u, ((0, 0), (CONV_LEFT, CONV_W - 1 - CONV_LEFT), (0, 0)))
    out = b
    for k in range(CONV_W):
        out = out + up[:, k:k + T] * w[k]
    return out


def _rglru_coeffs(u, w_a, b_a, w_i, b_i, lam):
    B, T, C = u.shape
    uh = u.reshape(B, T, LRU_HEADS, LRU_HD)
    r = jax.nn.sigmoid(jnp.einsum('bthi,hij->bthj', uh, w_a).reshape(B, T, C) + b_a)
    i = jax.nn.sigmoid(jnp.einsum('bthi,hij->bthj', uh, w_i).reshape(B, T, C) + b_i)
    log_a = -LRU_C * r * jax.nn.softplus(-lam.astype(jnp.float32))
    a = jnp.exp(log_a)
    bterm = jnp.sqrt(-jnp.expm1(2.0 * log_a)) * (i * u)
    return a, bterm


def _affine_combine(l, r):
    return (l[0] * r[0], r[0] * l[1] + r[1])


def _linear_scan(a, b, h0, reverse):
    if reverse:
        a, b = jnp.flip(a, 1), jnp.flip(b, 1)
    A, Bc = lax.associative_scan(_affine_combine, (a, b), axis=1)
    h = Bc + A * h0[:, None, :]
    return jnp.flip(h, 1) if reverse else h


def _fourier(f):
    B, T, _ = f.shape
    fg = f.astype(jnp.float32).reshape(B, T, FFT_GROUPS, FFT_GD)
    out = jnp.fft.fft2(fg, axes=(1, 3), norm='ortho').real
    return out.reshape(B, T, FFT_W).astype(f.dtype)


def _ab_mixer(hx, hc, w_in, conv_w, conv_b, w_a, b_a, w_i, b_i, lam, w_out, need_ctx):
    zx = hx @ w_in
    zc = hc @ w_in
    ux, gx, fx = zx[..., :LRU_W], zx[..., LRU_W:2 * LRU_W], zx[..., 2 * LRU_W:]
    uc, gc, fc = zc[..., :LRU_W], zc[..., LRU_W:2 * LRU_W], zc[..., 2 * LRU_W:]
    ux = _dwconv(ux, conv_w, conv_b).astype(jnp.float32)
    uc = _dwconv(uc, conv_w, conv_b).astype(jnp.float32)
    rx = jnp.zeros_like(ux)
    hc_dirs = []
    for d in range(2):
        rev = d == 1
        ac, bc = _rglru_coeffs(uc, w_a[d], b_a[d], w_i[d], b_i[d], lam[d])
        hcs = _linear_scan(ac, bc, jnp.zeros_like(uc[:, 0]), rev)
        h_end = hcs[:, 0] if rev else hcs[:, -1]
        ax, bx = _rglru_coeffs(ux, w_a[d], b_a[d], w_i[d], b_i[d], lam[d])
        rx = rx + _linear_scan(ax, bx, h_end, rev)
        hc_dirs.append(hcs)
    yx = jnp.concatenate([rx.astype(hx.dtype) * jax.nn.gelu(gx), _fourier(fx)], axis=-1) @ w_out
    yc = None
    if need_ctx:
        rc = (hc_dirs[0] + hc_dirs[1]).astype(hc.dtype)
        yc = jnp.concatenate([rc * jax.nn.gelu(gc), _fourier(fc)], axis=-1) @ w_out
    return yx, yc


def _na_mixer(hx, hc, w_qkv, rpb, w_out, need_ctx):
    B, S, D = hx.shape
    L = hc.shape[1]
    R = S // GRID_W
    kh = min(NA_KH, R)
    scale = NA_HD ** -0.5
    qkv = (hx @ w_qkv).reshape(B, R, GRID_W, 3, NA_HEADS, NA_HD)
    q = qkv[:, :, :, 0] * scale
    k = qkv[:, :, :, 1]
    v = qkv[:, :, :, 2]
    qkv_c = (hc @ w_qkv).reshape(B, L, 3, NA_HEADS, NA_HD)
    qc, kc, vc = qkv_c[:, :, 0] * scale, qkv_c[:, :, 1], qkv_c[:, :, 2]
    row_start = jnp.clip(jnp.arange(R) - kh // 2, 0, R - kh)
    col_start = jnp.clip(jnp.arange(GRID_W) - NA_KW // 2, 0, GRID_W - NA_KW)
    col_idx = col_start[:, None] + jnp.arange(NA_KW)[None, :]
    dc = col_idx - jnp.arange(GRID_W)[:, None] + NA_KW - 1
    rpb_cols = rpb[:, :, dc]
    n_loc = kh * NA_KW

    def row_attend(args):
        r, q_r = args
        rs = row_start[r]
        k_r = lax.dynamic_slice_in_dim(k, rs, kh, axis=1)[:, :, col_idx]
        v_r = lax.dynamic_slice_in_dim(v, rs, kh, axis=1)[:, :, col_idx]
        dr = rs + jnp.arange(kh) - r + NA_KH - 1
        bias = jnp.transpose(rpb_cols[:, dr], (0, 2, 1, 3)).astype(jnp.float32)
        s_loc = jnp.einsum('bqhd,bkqjhd->bhqkj', q_r, k_r).astype(jnp.float32) + bias
        s_ctx = jnp.einsum('bqhd,blhd->bhql', q_r, kc).astype(jnp.float32)
        s = jnp.concatenate([s_loc.reshape(B, NA_HEADS, GRID_W, n_loc), s_ctx], axis=-1)
        p = jax.nn.softmax(s, axis=-1).astype(v.dtype)
        p_loc = p[..., :n_loc].reshape(B, NA_HEADS, GRID_W, kh, NA_KW)
        return (jnp.einsum('bhqkj,bkqjhd->bqhd', p_loc, v_r)
                + jnp.einsum('bhql,blhd->bqhd', p[..., n_loc:], vc))

    o = lax.map(row_attend, (jnp.arange(R), jnp.moveaxis(q, 1, 0)))
    yx = jnp.moveaxis(o, 0, 1).reshape(B, S, D) @ w_out
    yc = None
    if need_ctx:
        pc = jax.nn.softmax(jnp.einsum('bqhd,blhd->bhql', qc, kc).astype(jnp.float32), axis=-1)
        yc = jnp.einsum('bhql,blhd->bqhd', pc.astype(vc.dtype), vc).reshape(B, L, D) @ w_out
    return yx, yc


def _normal(k, shape, s):
    return jax.random.normal(k, shape, jnp.float32) * s


def setup_inputs(seed: int = 0) -> dict:
    key = jax.random.key(seed)
    ks = jax.random.split(key, 25)
    D, F = D_MODEL, FFN_HIDDEN
    u = jax.random.uniform(ks[20], (N_EVEN, 2, LRU_W), jnp.float32, minval=0.9, maxval=0.999)
    a0 = u ** (1.0 / LRU_C)
    return {
        'x': _normal(ks[0], (BATCH, SEQ, D), 1.0),
        'c': _normal(ks[1], (BATCH, D), 1.0),
        'ctx': _normal(ks[2], (BATCH, CTX_LEN, D), 1.0),
        'c_ctx': _normal(ks[3], (D,), 1.0),
        'w_mod': _normal(ks[4], (DEPTH, D, 6 * D), 0.5 * D ** -0.5),
        'b_mod': _normal(ks[5], (DEPTH, 6 * D), 0.02),
        'g_pre_mix': 1.0 + _normal(ks[6], (DEPTH, D), 0.02),
        'g_post_mix': 1.0 + _normal(ks[7], (DEPTH, D), 0.02),
        'g_pre_ffn': 1.0 + _normal(ks[8], (DEPTH, D), 0.02),
        'g_post_ffn': 1.0 + _normal(ks[9], (DEPTH, D), 0.02),
        'w_ffn_gate': _normal(ks[10], (DEPTH, D, F), D ** -0.5),
        'w_ffn_up': _normal(ks[11], (DEPTH, D, F), D ** -0.5),
        'w_ffn_down': _normal(ks[12], (DEPTH, F, D), F ** -0.5),
        'w_in_ab': _normal(ks[13], (N_EVEN, D, AB_IN), D ** -0.5),
        'conv_w': _normal(ks[14], (N_EVEN, CONV_W, LRU_W), CONV_W ** -0.5),
        'conv_b': _normal(ks[15], (N_EVEN, LRU_W), 0.02),
        'lru_w_a': _normal(ks[16], (N_EVEN, 2, LRU_HEADS, LRU_HD, LRU_HD), LRU_HD ** -0.5),
        'lru_b_a': _normal(ks[17], (N_EVEN, 2, LRU_W), 0.02),
        'lru_w_i': _normal(ks[18], (N_EVEN, 2, LRU_HEADS, LRU_HD, LRU_HD), LRU_HD ** -0.5),
        'lru_b_i': _normal(ks[19], (N_EVEN, 2, LRU_W), 0.02),
        'lru_lam': jnp.log(a0) - jnp.log1p(-a0),
        'w_out_ab': _normal(ks[21], (N_EVEN, LRU_W + FFT_W, D), (LRU_W + FFT_W) ** -0.5),
        'w_qkv_na': _normal(ks[22], (N_ODD, D, 3 * D), D ** -0.5),
        'rpb_na': _normal(ks[23], (N_ODD, NA_HEADS, 2 * NA_KH - 1, 2 * NA_KW - 1), 0.1),
        'w_out_na': _normal(ks[24], (N_ODD, D, D), D ** -0.5),
    }


def reference(x, c, ctx, c_ctx, w_mod, b_mod, g_pre_mix, g_post_mix, g_pre_ffn, g_post_ffn,
              w_ffn_gate, w_ffn_up, w_ffn_down, w_in_ab, conv_w, conv_b, lru_w_a, lru_b_a,
              lru_w_i, lru_b_i, lru_lam, w_out_ab, w_qkv_na, rpb_na, w_out_na):
    c_act = jax.nn.silu(c)
    cc_act = jax.nn.silu(c_ctx)
    for l in range(DEPTH):
        last = l == DEPTH - 1
        mx = (c_act @ w_mod[l] + b_mod[l])[:, None, :]
        mc = (cc_act @ w_mod[l] + b_mod[l])[None, None, :]
        sh1, sc1, gt1, sh2, sc2, gt2 = jnp.split(mx, 6, axis=-1)
        csh1, csc1, cgt1, csh2, csc2, cgt2 = jnp.split(mc, 6, axis=-1)
        hx = _modulate(x, g_pre_mix[l], sh1, sc1)
        hc = _modulate(ctx, g_pre_mix[l], csh1, csc1)
        if l % 2 == 0:
            e = l // 2
            yx, yc = _ab_mixer(hx, hc, w_in_ab[e], conv_w[e], conv_b[e], lru_w_a[e], lru_b_a[e],
                               lru_w_i[e], lru_b_i[e], lru_lam[e], w_out_ab[e], not last)
        else:
            o = l // 2
            yx, yc = _na_mixer(hx, hc, w_qkv_na[o], rpb_na[o], w_out_na[o], not last)
        x = x + gt1 * _rmsnorm(yx, g_post_mix[l])
        fx = _modulate(x, g_pre_ffn[l], sh2, sc2)
        x = x + gt2 * _rmsnorm(_swiglu(fx, w_ffn_gate[l], w_ffn_up[l], w_ffn_down[l]), g_post_ffn[l])
        if not last:
            ctx = ctx + cgt1 * _rmsnorm(yc, g_post_mix[l])
            fc = _modulate(ctx, g_pre_ffn[l], csh2, csc2)
            ctx = ctx + cgt2 * _rmsnorm(_swiglu(fc, w_ffn_gate[l], w_ffn_up[l], w_ffn_down[l]), g_post_ffn[l])
    return x
```

```cpp
#include <hip/hip_runtime.h>
#include <hip/hip_cooperative_groups.h>
#include <cstdio>
namespace cg = cooperative_groups;

typedef unsigned short u16;
using bf16x8 = __attribute__((ext_vector_type(8))) short;
using f32x4  = __attribute__((ext_vector_type(4))) float;
using f32x16 = __attribute__((ext_vector_type(16))) float;

#ifndef ONE_LAUNCH
#define ONE_LAUNCH 1
#endif

#define N_TOK 33792
#define N_X   32768
#define NTHR  512
#define VTHR  256
#define VTID ((int)(threadIdx.x & 255))
#define VBID ((int)(blockIdx.x * 2 + (threadIdx.x >> 8)))
#define VGRID ((int)(gridDim.x * 2))
#define SMEM_V 73728
#define LDSS  72
#define SMEM_BYTES 147456
#define EPSF 1e-6f

struct Params {
  const float *x, *c, *ctx, *c_ctx, *w_mod, *b_mod, *g_pre_mix, *g_post_mix, *g_pre_ffn, *g_post_ffn;
  const float *w_gate, *w_up, *w_down, *w_in_ab, *conv_w, *conv_b, *w_a, *b_a, *w_i, *b_i, *lam;
  const float *w_out_ab, *w_qkv, *rpb, *w_out_na;
  float* out;
  u16 *wt_in, *wt_outab, *wt_qkv, *wt_outna, *wt_gu, *wt_dn;
  float* mod;
  u16 *d64t, *sbm, *scm, *sxm, *wg;
  float2* summ;
  float* xc;
  u16 *hy, *zq, *zf, *cat;
  unsigned* bar;
};

__device__ __forceinline__ u16 f2bf(float f) {
  const __bf16 b = static_cast<__bf16>(f);
  return __builtin_bit_cast(u16, b);
}
__device__ __forceinline__ float bf2f(u16 h) { return __uint_as_float(((unsigned)h) << 16); }
__device__ __forceinline__ uint4 ldg16(const u16* p) { return *reinterpret_cast<const uint4*>(p); }
__device__ __forceinline__ uint4 gather8(const u16* p, unsigned off, unsigned stride) {
  unsigned v0 = p[off], v1 = p[off + stride], v2 = p[off + 2 * stride], v3 = p[off + 3 * stride];
  unsigned v4 = p[off + 4 * stride], v5 = p[off + 5 * stride], v6 = p[off + 6 * stride], v7 = p[off + 7 * stride];
  return make_uint4(v0 | (v1 << 16), v2 | (v3 << 16), v4 | (v5 << 16), v6 | (v7 << 16));
}
__device__ __forceinline__ uint4 gather8p(const u16* p, unsigned off, unsigned s1, unsigned s2) {
  unsigned v0 = p[off], v1 = p[off + s1], v2 = p[off + s2], v3 = p[off + s2 + s1];
  unsigned v4 = p[off + 2 * s2], v5 = p[off + 2 * s2 + s1], v6 = p[off + 3 * s2], v7 = p[off + 3 * s2 + s1];
  return make_uint4(v0 | (v1 << 16), v2 | (v3 << 16), v4 | (v5 << 16), v6 | (v7 << 16));
}
__device__ __forceinline__ float sigmoidf_(float x) { return __builtin_amdgcn_rcpf(1.f + __expf(-x)); }
template <int CTRL>
__device__ __forceinline__ float dpp_mov(float v) {
  return __int_as_float(__builtin_amdgcn_update_dpp(0, __float_as_int(v), CTRL, 0xF, 0xF, true));
}
__device__ __forceinline__ float row16_max(float v) {
  v = fmaxf(v, dpp_mov<0xB1>(v)); v = fmaxf(v, dpp_mov<0x4E>(v));
  v = fmaxf(v, dpp_mov<0x141>(v)); v = fmaxf(v, dpp_mov<0x140>(v));
  return v;
}
__device__ __forceinline__ float row16_sum(float v) {
  v += dpp_mov<0xB1>(v); v += dpp_mov<0x4E>(v);
  v += dpp_mov<0x141>(v); v += dpp_mov<0x140>(v);
  return v;
}
__device__ __forceinline__ float wave_sum(float v) {
#pragma unroll
  for (int o = 32; o > 0; o >>= 1) v += __shfl_xor(v, o);
  return v;
}

template <bool BNN, class AL, class BL>
__device__ __forceinline__ void gemm_tile_nn(const AL& al, const BL& bl, int K, u16* smem, f32x16 (&acc)[2][2]) {
  const int tid = VTID, lane = tid & 63, wid = tid >> 6;
  const int wm = wid >> 1, wn = wid & 1;
  u16* sA = smem;
  u16* sB = smem + 2 * 128 * LDSS;
#pragma unroll
  for (int i = 0; i < 2; ++i)
#pragma unroll
    for (int j = 0; j < 2; ++j)
#pragma unroll
      for (int r = 0; r < 16; ++r) acc[i][j][r] = 0.f;
  uint4 ra[4], rb[4];
  const int lr = tid >> 3, lk = (tid & 7) * 8;
  const int nr = tid & 127, nk = (tid >> 7) * 8;
  const int nkt = K >> 6;
#pragma unroll
  for (int i = 0; i < 4; ++i) {
    ra[i] = al(lr + 32 * i, lk);
    if (BNN) rb[i] = bl(nr, nk + 16 * i); else rb[i] = bl(lr + 32 * i, lk);
  }
#pragma unroll
  for (int i = 0; i < 4; ++i) {
    *reinterpret_cast<uint4*>(&sA[(lr + 32 * i) * LDSS + lk]) = ra[i];
    if (BNN) *reinterpret_cast<uint4*>(&sB[nr * LDSS + nk + 16 * i]) = rb[i];
    else     *reinterpret_cast<uint4*>(&sB[(lr + 32 * i) * LDSS + lk]) = rb[i];
  }
  __syncthreads();
  for (int kt = 0; kt < nkt; ++kt) {
    const bool more = (kt + 1 < nkt);
    if (more) {
      const int k0 = (kt + 1) << 6;
#pragma unroll
      for (int i = 0; i < 4; ++i) {
        ra[i] = al(lr + 32 * i, k0 + lk);
        if (BNN) rb[i] = bl(nr, k0 + nk + 16 * i); else rb[i] = bl(lr + 32 * i, k0 + lk);
      }
    }
    const u16* a = sA + (kt & 1) * 128 * LDSS;
    const u16* b = sB + (kt & 1) * 128 * LDSS;
#pragma unroll
    for (int s = 0; s < 4; ++s) {
      bf16x8 af[2], bfr[2];
#pragma unroll
      for (int i = 0; i < 2; ++i)
        af[i] = *reinterpret_cast<const bf16x8*>(&a[(wm * 64 + i * 32 + (lane & 31)) * LDSS + s * 16 + (lane >> 5) * 8]);
#pragma unroll
      for (int j = 0; j < 2; ++j)
        bfr[j] = *reinterpret_cast<const bf16x8*>(&b[(wn * 64 + j * 32 + (lane & 31)) * LDSS + s * 16 + (lane >> 5) * 8]);
#pragma unroll
      for (int i = 0; i < 2; ++i)
#pragma unroll
        for (int j = 0; j < 2; ++j)
          acc[i][j] = __builtin_amdgcn_mfma_f32_32x32x16_bf16(af[i], bfr[j], acc[i][j], 0, 0, 0);
    }
    if (more) {
      u16* a2 = sA + ((kt + 1) & 1) * 128 * LDSS;
      u16* b2 = sB + ((kt + 1) & 1) * 128 * LDSS;
#pragma unroll
      for (int i = 0; i < 4; ++i) {
        *reinterpret_cast<uint4*>(&a2[(lr + 32 * i) * LDSS + lk]) = ra[i];
        if (BNN) *reinterpret_cast<uint4*>(&b2[nr * LDSS + nk + 16 * i]) = rb[i];
        else     *reinterpret_cast<uint4*>(&b2[(lr + 32 * i) * LDSS + lk]) = rb[i];
      }
    }
    __syncthreads();
  }
}

template <bool BNN, class AL, class BL>
__device__ __forceinline__ void gemm_tile(const AL& al, const BL& bl, int K, u16* smem, f32x16 (&acc)[2][2]) {
  const int tid = VTID, lane = tid & 63, wid = tid >> 6;
  const int wm = wid >> 1, wn = wid & 1;
  u16* sA = smem;
  u16* sB = smem + 2 * 128 * LDSS;
#pragma unroll
  for (int i = 0; i < 2; ++i)
#pragma unroll
    for (int j = 0; j < 2; ++j)
#pragma unroll
      for (int r = 0; r < 16; ++r) acc[i][j][r] = 0.f;
  uint4 ra0[4], rb0[4], ra1[4], rb1[4];
  const int lr = tid >> 3, lk = (tid & 7) * 8;
  const int nr = tid & 127, nk = (tid >> 7) * 8;
  const int nkt = K >> 6;
#define G_LOAD(RA, RB, KT)                                                          \
  {                                                                                 \
    const int k0_ = (KT) << 6;                                                      \
    _Pragma("unroll") for (int i = 0; i < 4; ++i) {                                 \
      RA[i] = al(lr + 32 * i, k0_ + lk);                                            \
      if (BNN) RB[i] = bl(nr, k0_ + nk + 16 * i); else RB[i] = bl(lr + 32 * i, k0_ + lk); \
    }                                                                               \
  }
#define G_STORE(RA, RB, BUF)                                                        \
  {                                                                                 \
    u16* a2_ = sA + (BUF) * 128 * LDSS;                                             \
    u16* b2_ = sB + (BUF) * 128 * LDSS;                                             \
    _Pragma("unroll") for (int i = 0; i < 4; ++i) {                                 \
      *reinterpret_cast<uint4*>(&a2_[(lr + 32 * i) * LDSS + lk]) = RA[i];           \
      if (BNN) *reinterpret_cast<uint4*>(&b2_[nr * LDSS + nk + 16 * i]) = RB[i];    \
      else     *reinterpret_cast<uint4*>(&b2_[(lr + 32 * i) * LDSS + lk]) = RB[i];  \
    }                                                                               \
  }
#define G_FRAGS(AF, BF, S)                                                          \
  {                                                                                 \
    _Pragma("unroll") for (int i = 0; i < 2; ++i)                                   \
      AF[i] = *reinterpret_cast<const bf16x8*>(&a_[(wm * 64 + i * 32 + (lane & 31)) * LDSS + (S) * 16 + (lane >> 5) * 8]); \
    _Pragma("unroll") for (int j = 0; j < 2; ++j)                                   \
      BF[j] = *reinterpret_cast<const bf16x8*>(&b_[(wn * 64 + j * 32 + (lane & 31)) * LDSS + (S) * 16 + (lane >> 5) * 8]); \
  }
#define G_MMA(AF, BF)                                                               \
  {                                                                                 \
    _Pragma("unroll") for (int i = 0; i < 2; ++i)                                   \
    _Pragma("unroll") for (int j = 0; j < 2; ++j)                                   \
      acc[i][j] = __builtin_amdgcn_mfma_f32_32x32x16_bf16(AF[i], BF[j], acc[i][j], 0, 0, 0); \
  }
#define G_COMPUTE(BUF)                                                              \
  {                                                                                 \
    const u16* a_ = sA + (BUF) * 128 * LDSS;                                        \
    const u16* b_ = sB + (BUF) * 128 * LDSS;                                        \
    bf16x8 afA[2], bfA[2], afB[2], bfB[2];                                          \
    G_FRAGS(afA, bfA, 0)                                                            \
    G_FRAGS(afB, bfB, 1)                                                            \
    G_MMA(afA, bfA)                                                                 \
    __builtin_amdgcn_sched_barrier(0);                                              \
    G_FRAGS(afA, bfA, 2)                                                            \
    G_MMA(afB, bfB)                                                                 \
    __builtin_amdgcn_sched_barrier(0);                                              \
    G_FRAGS(afB, bfB, 3)                                                            \
    G_MMA(afA, bfA)                                                                 \
    __builtin_amdgcn_sched_barrier(0);                                              \
    G_MMA(afB, bfB)                                                                 \
  }
  G_LOAD(ra0, rb0, 0)
  G_STORE(ra0, rb0, 0)
  if (nkt > 1) G_LOAD(ra1, rb1, 1)
  __syncthreads();
  for (int kt = 0; kt < nkt; kt += 2) {
    if (kt + 2 < nkt) G_LOAD(ra0, rb0, kt + 2)
    G_COMPUTE(0)
    if (kt + 1 < nkt) G_STORE(ra1, rb1, 1)
    __syncthreads();
    if (kt + 1 >= nkt) break;
    if (kt + 3 < nkt) G_LOAD(ra1, rb1, kt + 3)
    G_COMPUTE(1)
    if (kt + 2 < nkt) G_STORE(ra0, rb0, 0)
    __syncthreads();
  }
#undef G_LOAD
#undef G_STORE
#undef G_COMPUTE
#undef G_FRAGS
#undef G_MMA
}

#define ACC_FOREACH(BODY)                                                          \
  {                                                                                \
    int tid_ = VTID;                                                               \
    asm volatile("" : "+v"(tid_));                                                 \
    const int lane_ = tid_ & 63, wid_ = tid_ >> 6;                                 \
    const int wm_ = wid_ >> 1, wn_ = wid_ & 1;                                     \
    _Pragma("unroll") for (int i_ = 0; i_ < 2; ++i_)                               \
    _Pragma("unroll") for (int j_ = 0; j_ < 2; ++j_)                               \
    _Pragma("unroll") for (int r_ = 0; r_ < 16; ++r_) {                            \
      const int row = wm_ * 64 + i_ * 32 + (r_ & 3) + 8 * (r_ >> 2) + 4 * (lane_ >> 5); \
      const int col = wn_ * 64 + j_ * 32 + (lane_ & 31);                           \
      const float v = acc[i_][j_][r_];                                             \
      BODY                                                                         \
    }                                                                              \
  }

#define LAS3 __attribute__((address_space(3)))
__device__ __forceinline__ void glds16(const u16* g, char* l) {
  __builtin_amdgcn_global_load_lds((const unsigned*)g, (LAS3 unsigned*)l, 16, 0, 0);
}
__device__ __forceinline__ void gemm256_tile(const u16* Ab, int lda, const u16* Bb, int ldb, int K, char* smem,
                                             f32x16 (&acc)[2][4]) {
  const int tid = threadIdx.x, lane = tid & 63, wid = tid >> 6;
  const int wm = wid >> 1, wn = wid & 1;
#pragma unroll
  for (int i = 0; i < 2; ++i)
#pragma unroll
    for (int j = 0; j < 4; ++j)
#pragma unroll
      for (int r = 0; r < 16; ++r) acc[i][j][r] = 0.f;
  int nks = K >> 5;
  asm volatile("" : "+s"(nks));
  const int drow = wid * 16 + (lane >> 2);
  const int dk = ((lane & 3) ^ ((lane >> 4) & 3)) * 8;
  const unsigned ga0 = (unsigned)(drow * lda + dk), ga1 = (unsigned)((drow + 128) * lda + dk);
  const unsigned gb0 = (unsigned)(drow * ldb + dk), gb1 = (unsigned)((drow + 128) * ldb + dk);
  const unsigned dl0 = (unsigned)((wid * 64 + lane) * 16), dl1 = (unsigned)(((8 + wid) * 64 + lane) * 16);
#define DMA_STAGE(S)                                                     \
  {                                                                      \
    const int k0_ = (S) << 5;                                            \
    char* sb_ = smem + ((S) & 3) * 32768;                                \
    glds16(Ab + ga0 + k0_, sb_ + dl0);                                   \
    glds16(Ab + ga1 + k0_, sb_ + dl1);                                   \
    glds16(Bb + gb0 + k0_, sb_ + 16384 + dl0);                           \
    glds16(Bb + gb1 + k0_, sb_ + 16384 + dl1);                           \
  }
  const int xsw = (lane >> 2) & 3, hh = lane >> 5;
  const unsigned fo0 = (unsigned)((hh ^ xsw) * 16), fo1 = (unsigned)(((2 + hh) ^ xsw) * 16);
  const unsigned fa = (unsigned)((wm * 64 + (lane & 31)) * 64);
  const unsigned fb = (unsigned)(16384 + (wn * 128 + (lane & 31)) * 64);
#define G_FRAGS(AF, BF, Q, FO)                                                                       \
  {                                                                                                  \
    const char* sb_ = smem + (Q) * 32768;                                                            \
    _Pragma("unroll") for (int i = 0; i < 2; ++i)                                                    \
      AF[i] = *reinterpret_cast<const bf16x8*>(sb_ + fa + i * 2048 + FO);                            \
    _Pragma("unroll") for (int j = 0; j < 4; ++j)                                                    \
      BF[j] = *reinterpret_cast<const bf16x8*>(sb_ + fb + j * 2048 + FO);                            \
  }
#define G_MMA(AF, BF)                                                               \
  {                                                                                 \
    __builtin_amdgcn_s_setprio(1);                                                  \
    _Pragma("unroll") for (int i = 0; i < 2; ++i)                                   \
    _Pragma("unroll") for (int j = 0; j < 4; ++j)                                   \
      acc[i][j] = __builtin_amdgcn_mfma_f32_32x32x16_bf16(AF[i], BF[j], acc[i][j], 0, 0, 0); \
    __builtin_amdgcn_s_setprio(0);                                                  \
  }
#define G_WAIT_BAR(S)                                                                              \
  {                                                                                                \
    if ((S) + 3 < nks)      asm volatile("s_waitcnt vmcnt(8) lgkmcnt(0)\n\ts_barrier" ::: "memory"); \
    else if ((S) + 2 < nks) asm volatile("s_waitcnt vmcnt(4) lgkmcnt(0)\n\ts_barrier" ::: "memory"); \
    else                    asm volatile("s_waitcnt vmcnt(0) lgkmcnt(0)\n\ts_barrier" ::: "memory"); \
  }
  asm volatile("s_waitcnt vmcnt(0)" ::: "memory");
  const bool h1 = __builtin_amdgcn_readfirstlane(wid) >= 4;
#define LGKM0_BAR asm volatile("s_waitcnt lgkmcnt(0)\n\ts_barrier" ::: "memory");
  DMA_STAGE(0)
  if (nks > 1) DMA_STAGE(1)
  if (nks > 2) DMA_STAGE(2)
  if (nks > 3) DMA_STAGE(3)
  if (nks > 3)      asm volatile("s_waitcnt vmcnt(12)\n\ts_barrier" ::: "memory");
  else if (nks > 2) asm volatile("s_waitcnt vmcnt(8)\n\ts_barrier" ::: "memory");
  else if (nks > 1) asm volatile("s_waitcnt vmcnt(4)\n\ts_barrier" ::: "memory");
  else              asm volatile("s_waitcnt vmcnt(0)\n\ts_barrier" ::: "memory");
  bf16x8 afA[2], bfA[4], afB[2], bfB[4];
  if (!h1) {
    G_FRAGS(afA, bfA, 0, fo0)
    LGKM0_BAR
    for (int s = 0; s < nks; ++s) {
      const int q = s & 3;
      G_MMA(afA, bfA)
      __builtin_amdgcn_sched_barrier(0);
      LGKM0_BAR
      G_FRAGS(afB, bfB, q, fo1)
      __builtin_amdgcn_sched_barrier(0);
      LGKM0_BAR
      G_MMA(afB, bfB)
      __builtin_amdgcn_sched_barrier(0);
      G_WAIT_BAR(s)
      if (s + 4 < nks) DMA_STAGE(s + 4)
      if (s + 1 < nks) G_FRAGS(afA, bfA, (s + 1) & 3, fo0)
      __builtin_amdgcn_sched_barrier(0);
      LGKM0_BAR
    }
  } else {
    LGKM0_BAR
    for (int s = 0; s < nks; ++s) {
      const int q = s & 3;
      G_FRAGS(afA, bfA, q, fo0)
      __builtin_amdgcn_sched_barrier(0);
      LGKM0_BAR
      G_MMA(afA, bfA)
      __builtin_amdgcn_sched_barrier(0);
      LGKM0_BAR
      G_FRAGS(afB, bfB, q, fo1)
      __builtin_amdgcn_sched_barrier(0);
      G_WAIT_BAR(s)
      G_MMA(afB, bfB)
      __builtin_amdgcn_sched_barrier(0);
      if (s + 4 < nks) DMA_STAGE(s + 4)
      __builtin_amdgcn_sched_barrier(0);
      LGKM0_BAR
    }
  }
#undef LGKM0_BAR
  __syncthreads();
#undef DMA_STAGE
#undef G_FRAGS
#undef G_MMA
#undef G_WAIT_BAR
}

__device__ __forceinline__ void tile_map256(int t, int Mt, int Nt, int& mt, int& nt) {
  const int nT = Mt * Nt;
  const int x = t & 7, w = t >> 3, q = nT >> 3, r = nT & 7;
  const int L = (x < r ? x * (q + 1) : r * (q + 1) + (x - r) * q) + w;
  const int per = 4 * Nt;
  const int grp = L / per, jj = L - grp * per;
  nt = jj >> 2;
  mt = grp * 4 + (jj & 3);
}

__device__ __forceinline__ void gemm_nt_phase(const u16* A, int lda, const u16* Bt, int ldb, u16* C, int ldc,
                              int Mt, int Nt, int K, int qcols, float qscale, u16* smem,
                              u16* vtx = nullptr, u16* vtc = nullptr, u16* smv = nullptr) {
  if (smv != nullptr) {
    const int NtS = Nt * 2, nS = 8 * NtS;
    for (int t = VBID; t < nS; t += VGRID) {
      const int ms = t / NtS, ns = t - ms * NtS;
      const u16* Ab = A + (long)(N_X + ms * 128) * lda;
      const u16* Bb = Bt + (long)ns * 128 * ldb;
      auto al = [=](int r, int k) { return ldg16(Ab + (unsigned)(r * lda + k)); };
      auto bl = [=](int r, int k) { return ldg16(Bb + (unsigned)(r * ldb + k)); };
      f32x16 acc[2][2];
      gemm_tile<false>(al, bl, K, smv, acc);
      u16* Cb = C + (long)(N_X + ms * 128) * ldc + ns * 128;
      if (vtc != nullptr && ns >= 16) {
        u16* Vb = vtc + (long)(ms >> 1) * 1024 * 256 + (long)(ns - 16) * 128 * 256 + (ms & 1) * 128;
        ACC_FOREACH({ Vb[(unsigned)(col * 256 + row)] = f2bf(v); })
      } else {
        ACC_FOREACH({ Cb[(unsigned)(row * ldc + col)] = f2bf(v); })
      }
    }
    __syncthreads();
    Mt = 128;
  }
  const int nT = Mt * Nt;
  for (int t = blockIdx.x; t < nT; t += gridDim.x) {
    int mt, nt; tile_map256(t, Mt, Nt, mt, nt);
    const u16* Ab = A + (long)mt * 256 * lda;
    const u16* Bb = Bt + (long)nt * 256 * ldb;
    f32x16 acc[2][4];
    gemm256_tile(Ab, lda, Bb, ldb, K, reinterpret_cast<char*>(smem), acc);
    u16* Cb = C + (long)mt * 256 * ldc + nt * 256;
    const float sc = (nt * 256 < qcols) ? qscale : 1.f;
    int tid_ = threadIdx.x;
    asm volatile("" : "+v"(tid_));
    const int lane = tid_ & 63, wid = tid_ >> 6, wm = wid >> 1, wn = wid & 1;
    if (vtx != nullptr && nt >= 8) {
      u16* dst; unsigned tstride;
      if (mt < 128) { dst = vtx + (long)(mt >> 5) * 1024 * 8192 + (mt & 31) * 256; tstride = 8192; }
      else          { dst = vtc + (long)(mt - 128) * 1024 * 256; tstride = 256; }
#pragma unroll
      for (int i = 0; i < 2; ++i)
#pragma unroll
        for (int j = 0; j < 4; ++j)
#pragma unroll
          for (int rq = 0; rq < 4; ++rq) {
            const int row = wm * 64 + i * 32 + 8 * rq + 4 * (lane >> 5);
            const int hd = (nt - 8) * 256 + wn * 128 + j * 32 + (lane & 31);
            const unsigned v0 = f2bf(acc[i][j][4 * rq + 0]), v1 = f2bf(acc[i][j][4 * rq + 1]);
            const unsigned v2 = f2bf(acc[i][j][4 * rq + 2]), v3 = f2bf(acc[i][j][4 * rq + 3]);
            *reinterpret_cast<uint2*>(&dst[(unsigned)(hd * tstride + row)]) = make_uint2(v0 | (v1 << 16), v2 | (v3 << 16));
          }
    } else {
      char* wb = reinterpret_cast<char*>(smem) + wid * 17408;
#pragma unroll
      for (int i = 0; i < 2; ++i)
#pragma unroll
        for (int j = 0; j < 4; ++j)
#pragma unroll
          for (int r = 0; r < 16; ++r) {
            const int row = i * 32 + (r & 3) + 8 * (r >> 2) + 4 * (lane >> 5);
            const int col = j * 32 + (lane & 31);
            *reinterpret_cast<u16*>(wb + row * 272 + col * 2) = f2bf(acc[i][j][r] * sc);
          }
      asm volatile("s_waitcnt lgkmcnt(0)" ::: "memory");
#pragma unroll
      for (int q = 0; q < 16; ++q) {
        const int idx = q * 64 + lane, row = idx >> 4, c16 = idx & 15;
        const uint4 v = *reinterpret_cast<const uint4*>(wb + row * 272 + c16 * 16);
        *reinterpret_cast<uint4*>(&Cb[(unsigned)((wm * 64 + row) * ldc + wn * 128 + c16 * 8)]) = v;
      }
    }
    __syncthreads();
  }
}

__device__ __forceinline__ void gemm_swiglu_phase(const u16* A, const u16* Bt, u16* C, int Mt, u16* smem, u16* smv = nullptr) {
  if (smv != nullptr) {
    const int NtS = 44, nS = 8 * NtS;
    for (int t = VBID; t < nS; t += VGRID) {
      const int ms = t / NtS, ns = t - ms * NtS;
      const u16* Ab = A + (long)(N_X + ms * 128) * 1024;
      const u16* Bb = Bt + (long)ns * 128 * 1024;
      auto al = [=](int r, int k) { return ldg16(Ab + (unsigned)(r * 1024 + k)); };
      auto bl = [=](int r, int k) { return ldg16(Bb + (unsigned)(r * 1024 + k)); };
      f32x16 acc[2][2];
      gemm_tile<false>(al, bl, 1024, smv, acc);
      int tid_ = VTID;
      asm volatile("" : "+v"(tid_));
      const int lane = tid_ & 63, wid = tid_ >> 6, wm = wid >> 1, wn = wid & 1;
      u16* Cb = C + (long)(N_X + ms * 128) * 2816 + ns * 64;
#pragma unroll
      for (int i = 0; i < 2; ++i)
#pragma unroll
        for (int r = 0; r < 16; ++r) {
          const int row = wm * 64 + i * 32 + (r & 3) + 8 * (r >> 2) + 4 * (lane >> 5);
          const float g = acc[i][0][r], u = acc[i][1][r];
          Cb[(unsigned)(row * 2816 + wn * 32 + (lane & 31))] = f2bf(g * sigmoidf_(g) * u);
        }
    }
    __syncthreads();
    Mt = 128;
  }
  const int Nt = 22, nT = Mt * Nt;
  for (int t = blockIdx.x; t < nT; t += gridDim.x) {
    int mt, nt; tile_map256(t, Mt, Nt, mt, nt);
    const u16* Ab = A + (long)mt * 256 * 1024;
    const u16* Bb = Bt + (long)nt * 256 * 1024;
    f32x16 acc[2][4];
    gemm256_tile(Ab, 1024, Bb, 1024, 1024, reinterpret_cast<char*>(smem), acc);
    int tid_ = threadIdx.x;
    asm volatile("" : "+v"(tid_));
    const int lane = tid_ & 63, wid = tid_ >> 6, wm = wid >> 1, wn = wid & 1;
    u16* Cb = C + (long)mt * 256 * 2816 + nt * 128;
    char* wb = reinterpret_cast<char*>(smem) + wid * 9216;
#pragma unroll
    for (int i = 0; i < 2; ++i)
#pragma unroll
      for (int jp = 0; jp < 2; ++jp)
#pragma unroll
        for (int r = 0; r < 16; ++r) {
          const int row = i * 32 + (r & 3) + 8 * (r >> 2) + 4 * (lane >> 5);
          const int col = jp * 32 + (lane & 31);
          const float g = acc[i][2 * jp][r], u = acc[i][2 * jp + 1][r];
          *reinterpret_cast<u16*>(wb + row * 144 + col * 2) = f2bf(g * sigmoidf_(g) * u);
        }
    asm volatile("s_waitcnt lgkmcnt(0)" ::: "memory");
#pragma unroll
    for (int q = 0; q < 8; ++q) {
      const int idx = q * 64 + lane, row = idx >> 3, c16 = idx & 7;
      const uint4 v = *reinterpret_cast<const uint4*>(wb + row * 144 + c16 * 16);
      *reinterpret_cast<uint4*>(&Cb[(unsigned)((wm * 64 + row) * 2816 + wn * 64 + c16 * 8)]) = v;
    }
    __syncthreads();
  }
}

__device__ __forceinline__ void transpose_tile(const float* src, int ldn, int k0, int n0, u16* dst, int ldk, int mode, float* sm) {
  const int tid = VTID;
  const int cc = tid & 63, rr = tid >> 6;
#pragma unroll 4
  for (int i = 0; i < 16; ++i) {
    const int r = rr + 4 * i;
    sm[r * 65 + cc] = src[(long)(k0 + r) * ldn + n0 + cc];
  }
  __syncthreads();
#pragma unroll
  for (int i = 0; i < 2; ++i) {
    const int n = (tid >> 3) + 32 * i, kg = tid & 7;
    unsigned v[8];
#pragma unroll
    for (int j = 0; j < 8; ++j) v[j] = f2bf(sm[(kg * 8 + j) * 65 + n]);
    const int gn = n0 + n;
    int drow = gn;
    if (mode == 1) drow = (gn >> 5) * 64 + (gn & 31);
    else if (mode == 2) drow = (gn >> 5) * 64 + 32 + (gn & 31);
    *reinterpret_cast<uint4*>(&dst[(long)drow * ldk + k0 + kg * 8]) =
        make_uint4(v[0] | (v[1] << 16), v[2] | (v[3] << 16), v[4] | (v[5] << 16), v[6] | (v[7] << 16));
  }
  __syncthreads();
}

__device__ __forceinline__ void mod_gemv_item(const Params& P, int item, float* sm) {
  const int tid = VTID;
  const int l = item / 96, jg = item % 96;
  for (int idx = tid; idx < 5120; idx += VTHR) {
    const int m = idx >> 10, k = idx & 1023;
    const float v = (m < 4) ? P.c[m * 1024 + k] : P.c_ctx[k];
    sm[idx] = v / (1.f + __expf(-v));
  }
  __syncthreads();
  const int kq = tid >> 6, jj = tid & 63;
  float a0 = 0, a1 = 0, a2 = 0, a3 = 0, a4 = 0;
  const float* w = P.w_mod + ((long)l * 1024 + kq * 256) * 6144 + jg * 64 + jj;
  const float* s = sm + kq * 256;
#pragma unroll 8
  for (int k = 0; k < 256; ++k) {
    const float wv = w[(long)k * 6144];
    a0 += s[k] * wv; a1 += s[1024 + k] * wv; a2 += s[2048 + k] * wv; a3 += s[3072 + k] * wv; a4 += s[4096 + k] * wv;
  }
  float* red = sm + 5120;
  red[(kq * 5 + 0) * 64 + jj] = a0; red[(kq * 5 + 1) * 64 + jj] = a1; red[(kq * 5 + 2) * 64 + jj] = a2;
  red[(kq * 5 + 3) * 64 + jj] = a3; red[(kq * 5 + 4) * 64 + jj] = a4;
  __syncthreads();
  for (int idx = tid; idx < 320; idx += VTHR) {
    const int m = idx >> 6, j = idx & 63;
    const float v = red[(0 * 5 + m) * 64 + j] + red[(1 * 5 + m) * 64 + j] + red[(2 * 5 + m) * 64 + j] + red[(3 * 5 + m) * 64 + j];
    const int col = jg * 64 + j;
    P.mod[(long)(l * 5 + m) * 6144 + col] = v + P.b_mod[l * 6144 + col];
  }
  __syncthreads();
}

__device__ __forceinline__ void const_item(const Params& P, int item) {
  const int tid = VTID;
#pragma unroll 1
  for (int i = 0; i < 8; ++i) {
    const int off = tid + 256 * i;
    if (item < 1024) {
      const int e = item * 2048 + off;
      const int t2 = e >> 14, m = (e >> 7) & 127, k = e & 127;
      const int ro = m & 1, k1 = m >> 1, ri = k & 1, t1 = k >> 1;
      const int idx = (k1 * t1 * 128 + k1 * t2) & 8191;
      float sn, cs;
      sincospif((float)idx * (1.f / 4096.f), &sn, &cs);
      const float v = (ro == ri) ? cs : (ro == 0 ? sn : -sn);
      P.sbm[e] = f2bf(v * 0.125f);
    } else if (item < 1024 + 64) {
      const int e = (item - 1024) * 2048 + off;
      const int m = e >> 9, kk = e & 511, ri = kk & 1, t = kk >> 1;
      const int idx = (m * t) & 255;
      float sn, cs;
      sincospif((float)idx * (1.f / 128.f), &sn, &cs);
      P.sxm[e] = f2bf((ri == 0 ? cs : sn) * 0.0625f);
    } else if (item < 1024 + 128) {
      const int e = (item - 1088) * 2048 + off;
      const int ii = e & 63, j = (e >> 6) & 63, ai = (e >> 12) & 1, h = (e >> 13) & 7, d = e >> 16;
      const float* src = ai ? P.w_i : P.w_a;
      P.wg[e] = f2bf(src[((long)(d * 8 + h) * 64 + ii) * 64 + j] * -1.4426950408889634f);
    } else if (item < 1024 + 128 + 16) {
      const int e = (item - 1152) * 2048 + off;
      const int m = e >> 8, k = e & 255, ro = k >> 7, t2 = k & 127;
      const int idx = (m * t2) & 127;
      float sn, cs;
      sincospif((float)idx * (1.f / 64.f), &sn, &cs);
      P.scm[e] = f2bf((ro == 0 ? cs : sn) * 0.08838834764831845f);
    } else {
      const int e = (item - 1168) * 2048 + off;
      const int n = e >> 6, c = e & 63, ri = n >> 6, j = n & 63;
      const int idx = (j * c) & 63;
      float sn, cs;
      sincospif((float)idx * (1.f / 32.f), &sn, &cs);
      P.d64t[e] = f2bf((ri == 0 ? cs : -sn) * 0.125f);
    }
  }
}

__device__ __forceinline__ void prep_phase(const Params& P, float* sm) {
  const int NG = 192, NTR = 5888, NC = 1172;
  for (int it = VBID; it < NG; it += VGRID) mod_gemv_item(P, it, sm);
  for (int tt = VBID; tt < NTR; tt += VGRID) {
    int t = tt;
    const float* src; u16* dst; int ldn, ldk, mode = 0, kt, ntl;
    if (t < 384) { src = P.w_in_ab; dst = P.wt_in; ldn = 1536; ldk = 1024; kt = t / 24; ntl = t % 24; }
    else if (t < 640) { t -= 384; src = P.w_out_ab; dst = P.wt_outab; ldn = 1024; ldk = 1024; kt = t / 16; ntl = t % 16; }
    else if (t < 1408) { t -= 640; src = P.w_qkv; dst = P.wt_qkv; ldn = 3072; ldk = 1024; kt = t / 48; ntl = t % 48; }
    else if (t < 1664) { t -= 1408; src = P.w_out_na; dst = P.wt_outna; ldn = 1024; ldk = 1024; kt = t / 16; ntl = t % 16; }
    else if (t < 1664 + 2816) {
      t -= 1664;
      const int which = t / 704, tq = t % 704;
      const int l = which & 1, isup = which >> 1;
      src = (isup ? P.w_up : P.w_gate) + (long)l * 1024 * 2816;
      dst = P.wt_gu + (long)l * 5632 * 1024;
      ldn = 2816; ldk = 1024; mode = isup ? 2 : 1; kt = tq / 44; ntl = tq % 44;
    } else {
      t -= 1664 + 2816;
      const int l = t / 704, tq = t % 704;
      src = P.w_down + (long)l * 2816 * 1024;
      dst = P.wt_dn + (long)l * 1024 * 2816;
      ldn = 1024; ldk = 2816; kt = tq / 16; ntl = tq % 16;
    }
    transpose_tile(src, ldn, kt * 64, ntl * 64, dst, ldk, mode, sm);
  }
  for (int it = VBID; it < NC; it += VGRID) const_item(P, it);
}

__device__ __forceinline__ void row_phase(const Params& P, int glayer, int layer, int xsrc, bool hasY, int gate_idx, const float* gpost,
                          int xdst, bool doH, const float* gpre, int sh_idx, int nrows) {
  const int lane = threadIdx.x & 63, wid = threadIdx.x >> 6;
  const int stride = gridDim.x * 8;
  u16* resA = reinterpret_cast<u16*>(P.out);
  for (int rb = blockIdx.x * 8 + wid; rb < nrows; rb += 4 * stride) {
    uint4 xr[4][4];
    uint2 yy[4][4];
#pragma unroll
    for (int u = 0; u < 4; ++u) {
      const int R = rb + u * stride;
      if (R < nrows) {
        if (xsrc != 0 && R < N_X) {
          const u16* xs_ = ((xsrc == 1) ? resA : P.zf) + (long)R * 1024;
#pragma unroll
          for (int i = 0; i < 4; ++i) {
            const uint2 t2 = *reinterpret_cast<const uint2*>(xs_ + (i * 64 + lane) * 4);
            xr[u][i].x = t2.x; xr[u][i].y = t2.y;
          }
        } else {
          const float* xin_;
          if (xsrc == 0) xin_ = R < N_X ? P.x + (long)R * 1024 : P.ctx + (long)(R - N_X) * 1024;
          else           xin_ = P.xc + (long)(R - N_X) * 1024;
#pragma unroll
          for (int i = 0; i < 4; ++i) xr[u][i] = *reinterpret_cast<const uint4*>(xin_ + (i * 64 + lane) * 4);
        }
        if (hasY) {
          const u16* y_ = P.hy + (long)R * 1024;
#pragma unroll
          for (int i = 0; i < 4; ++i) yy[u][i] = *reinterpret_cast<const uint2*>(y_ + (i * 64 + lane) * 4);
        }
      }
    }
#pragma unroll
    for (int u = 0; u < 4; ++u) {
      const int row = rb + u * stride;
      if (row < nrows) {
        const int mi = row < N_X ? (row >> 13) : 4;
        const float* modp = P.mod + (long)(layer * 5 + mi) * 6144;
        const float* modg = P.mod + (long)(glayer * 5 + mi) * 6144;
        float4 xv[4];
        if (xsrc != 0 && row < N_X) {
#pragma unroll
          for (int i = 0; i < 4; ++i) {
            const uint4 raw = xr[u][i];
            xv[i].x = bf2f((u16)(raw.x & 0xffff)); xv[i].y = bf2f((u16)(raw.x >> 16));
            xv[i].z = bf2f((u16)(raw.y & 0xffff)); xv[i].w = bf2f((u16)(raw.y >> 16));
          }
        } else {
#pragma unroll
          for (int i = 0; i < 4; ++i) {
            xv[i].x = __uint_as_float(xr[u][i].x); xv[i].y = __uint_as_float(xr[u][i].y);
            xv[i].z = __uint_as_float(xr[u][i].z); xv[i].w = __uint_as_float(xr[u][i].w);
          }
        }
        if (hasY) {
          float4 yv[4];
          float ss = 0.f;
#pragma unroll
          for (int i = 0; i < 4; ++i) {
            const uint2 raw = yy[u][i];
            yv[i].x = bf2f((u16)(raw.x & 0xffff)); yv[i].y = bf2f((u16)(raw.x >> 16));
            yv[i].z = bf2f((u16)(raw.y & 0xffff)); yv[i].w = bf2f((u16)(raw.y >> 16));
            ss += yv[i].x * yv[i].x + yv[i].y * yv[i].y + yv[i].z * yv[i].z + yv[i].w * yv[i].w;
          }
          ss = wave_sum(ss);
          const float rstd = __builtin_amdgcn_rsqf(ss * (1.f / 1024.f) + EPSF);
#pragma unroll
          for (int i = 0; i < 4; ++i) {
            const int col = (i * 64 + lane) * 4;
            const float4 gt = *reinterpret_cast<const float4*>(modg + gate_idx * 1024 + col);
            const float4 gp = *reinterpret_cast<const float4*>(gpost + col);
            xv[i].x += gt.x * (yv[i].x * rstd * gp.x); xv[i].y += gt.y * (yv[i].y * rstd * gp.y);
            xv[i].z += gt.z * (yv[i].z * rstd * gp.z); xv[i].w += gt.w * (yv[i].w * rstd * gp.w);
          }
        }
        if (xdst == 3 || (xdst == 1 && row >= N_X)) {
          float* xout = (xdst == 3) ? P.out + (long)row * 1024 : P.xc + (long)(row - N_X) * 1024;
#pragma unroll
          for (int i = 0; i < 4; ++i) *reinterpret_cast<float4*>(xout + (i * 64 + lane) * 4) = xv[i];
        } else if (xdst != 0) {
          u16* xo = ((xdst == 1) ? resA : P.zf) + (long)row * 1024;
#pragma unroll
          for (int i = 0; i < 4; ++i) {
            const unsigned b0 = f2bf(xv[i].x), b1 = f2bf(xv[i].y), b2 = f2bf(xv[i].z), b3 = f2bf(xv[i].w);
            *reinterpret_cast<uint2*>(xo + (i * 64 + lane) * 4) = make_uint2(b0 | (b1 << 16), b2 | (b3 << 16));
          }
        }
        if (doH) {
          float ss = 0.f;
#pragma unroll
          for (int i = 0; i < 4; ++i) ss += xv[i].x * xv[i].x + xv[i].y * xv[i].y + xv[i].z * xv[i].z + xv[i].w * xv[i].w;
          ss = wave_sum(ss);
          const float rstd = __builtin_amdgcn_rsqf(ss * (1.f / 1024.f) + EPSF);
          u16* h = P.hy + (long)row * 1024;
#pragma unroll
          for (int i = 0; i < 4; ++i) {
            const int col = (i * 64 + lane) * 4;
            const float4 g = *reinterpret_cast<const float4*>(gpre + col);
            const float4 sh = *reinterpret_cast<const float4*>(modp + sh_idx * 1024 + col);
            const float4 sc = *reinterpret_cast<const float4*>(modp + (sh_idx + 1) * 1024 + col);
            const unsigned h0 = f2bf(xv[i].x * rstd * g.x * (1.f + sc.x) + sh.x);
            const unsigned h1 = f2bf(xv[i].y * rstd * g.y * (1.f + sc.y) + sh.y);
            const unsigned h2 = f2bf(xv[i].z * rstd * g.z * (1.f + sc.z) + sh.z);
            const unsigned h3 = f2bf(xv[i].w * rstd * g.w * (1.f + sc.w) + sh.w);
            *reinterpret_cast<uint2*>(h + col) = make_uint2(h0 | (h1 << 16), h2 | (h3 << 16));
          }
        }
      }
    }
  }
}

__device__ __forceinline__ void lru_tile(const Params& P, int chunk, int head, int pass, char* smem_raw) {
  u16* sm_uc = reinterpret_cast<u16*>(smem_raw);
  u16* sm_w = sm_uc + 128 * LDSS;
  float* sm_a = reinterpret_cast<float*>(sm_w + 128 * LDSS);
  float* sm_b = sm_a + 64 * 64;
  float2* sm_ph = reinterpret_cast<float2*>(sm_b + 64 * 64);
  float* sm_init = reinterpret_cast<float*>(sm_ph + 256);
  const int tid = VTID, lane = tid & 63, wid = tid >> 6;
  const int q = tid >> 6, ch = tid & 63;
  const int row0 = chunk * 128;
  int seq_lo, seq_hi;
  if (chunk < 256) { seq_lo = (chunk >> 6) << 13; seq_hi = seq_lo + 8192; }
  else { const int b = (chunk - 256) >> 1; seq_lo = N_X + b * 256; seq_hi = seq_lo + 256; }
  const int gch = head * 64 + ch;
  const float* hfbuf = reinterpret_cast<const float*>(P.hy);
  float* hfw = reinterpret_cast<float*>(P.hy);
  __syncthreads();
  uint4 wreg[4];
#pragma unroll
  for (int i = 0; i < 4; ++i) {
    const int idx = tid + 256 * i, rowi = idx >> 3, kg = idx & 7;
    wreg[i] = ldg16(P.wg + ((long)(0 * 8 + head) * 128 + rowi) * 64 + kg * 8);
  }
  {
    const float w0 = P.conv_w[gch], w1 = P.conv_w[512 + gch], w2 = P.conv_w[1024 + gch], w3 = P.conv_w[1536 + gch];
    const float cb = P.conv_b[gch];
    const u16* zu = P.zq + gch;
    const int r = row0 + q * 32;
    float uv[35];
#pragma unroll
    for (int i = 0; i < 35; ++i) {
      const int rr = r - 2 + i;
      uv[i] = (rr >= seq_lo && rr < seq_hi) ? bf2f(zu[(long)rr * 1536]) : 0.f;
    }
#pragma unroll
    for (int i = 0; i < 32; ++i) {
      const float v = cb + uv[i] * w0 + uv[i + 1] * w1 + uv[i + 2] * w2 + uv[i + 3] * w3;
      sm_uc[(q * 32 + i) * LDSS + ch] = f2bf(v);
    }
  }
  if (pass == 2 && tid < 128) {
    const int d = tid >> 6;
    float h = 0.f;
    const float2* S = P.summ + (long)d * 264 * 512 + gch;
    if (chunk < 256) {
      const int b = chunk >> 6, j = chunk & 63;
      if (d == 0) {
        float2 s = S[(long)(256 + 2 * b) * 512]; h = s.x * h + s.y;
        s = S[(long)(256 + 2 * b + 1) * 512]; h = s.x * h + s.y;
        int i = 0;
        for (; i + 8 <= j; i += 8) {
          float2 sv[8];
#pragma unroll
          for (int u = 0; u < 8; ++u) sv[u] = S[(long)(b * 64 + i + u) * 512];
#pragma unroll
          for (int u = 0; u < 8; ++u) h = sv[u].x * h + sv[u].y;
        }
        for (; i < j; ++i) { s = S[(long)(b * 64 + i) * 512]; h = s.x * h + s.y; }
      } else {
        float2 s = S[(long)(256 + 2 * b + 1) * 512]; h = s.x * h + s.y;
        s = S[(long)(256 + 2 * b) * 512]; h = s.x * h + s.y;
        int i = 63;
        for (; i - 8 >= j; i -= 8) {
          float2 sv[8];
#pragma unroll
          for (int u = 0; u < 8; ++u) sv[u] = S[(long)(b * 64 + i - u) * 512];
#pragma unroll
          for (int u = 0; u < 8; ++u) h = sv[u].x * h + sv[u].y;
        }
        for (; i > j; --i) { s = S[(long)(b * 64 + i) * 512]; h = s.x * h + s.y; }
      }
    } else {
      const int b = (chunk - 256) >> 1, j = (chunk - 256) & 1;
      if (d == 0) { if (j == 1) { const float2 s = S[(long)(256 + 2 * b) * 512]; h = s.y; } }
      else        { if (j == 0) { const float2 s = S[(long)(256 + 2 * b + 1) * 512]; h = s.y; } }
    }
    sm_init[d * 64 + ch] = h;
  }
  for (int d = 0; d < 2; ++d) {
    __syncthreads();
#pragma unroll
    for (int i = 0; i < 4; ++i) {
      const int idx = tid + 256 * i, rowi = idx >> 3, kg = idx & 7;
      *reinterpret_cast<uint4*>(&sm_w[rowi * LDSS + kg * 8]) = wreg[i];
    }
    if (d == 0) {
#pragma unroll
      for (int i = 0; i < 4; ++i) {
        const int idx = tid + 256 * i, rowi = idx >> 3, kg = idx & 7;
        wreg[i] = ldg16(P.wg + ((long)(1 * 8 + head) * 128 + rowi) * 64 + kg * 8);
      }
    }
    float ba[4], bi[4], c8[4];
#pragma unroll
    for (int tc = 0; tc < 4; ++tc) {
      const int cidx = d * 512 + head * 64 + 16 * tc + (lane & 15);
      ba[tc] = P.b_a[cidx] * -1.4426950408889634f; bi[tc] = P.b_i[cidx] * -1.4426950408889634f;
      const float nl = -P.lam[cidx];
      const float e_ = __expf(nl);
      const float sp = (nl > 20.f) ? nl
                     : (e_ < 0.03f ? e_ * (1.f - e_ * (0.5f - e_ * (0.33333334f - 0.25f * e_))) : __logf(1.f + e_));
      c8[tc] = 8.f * 1.4426950408889634f * sp;
    }
    __syncthreads();
    float cA = 1.f, cB = (pass == 2) ? sm_init[d * 64 + ch] : 0.f;
    for (int sbi = 0; sbi < 2; ++sbi) {
      const int sb = (d == 0) ? sbi : 1 - sbi;
      f32x4 acc[8];
#pragma unroll
      for (int t = 0; t < 8; ++t) acc[t] = f32x4{0.f, 0.f, 0.f, 0.f};
#pragma unroll
      for (int s = 0; s < 2; ++s) {
        const bf16x8 af = *reinterpret_cast<const bf16x8*>(&sm_uc[(sb * 64 + wid * 16 + (lane & 15)) * LDSS + s * 32 + (lane >> 4) * 8]);
#pragma unroll
        for (int t = 0; t < 8; ++t) {
          const bf16x8 bfr = *reinterpret_cast<const bf16x8*>(&sm_w[(t * 16 + (lane & 15)) * LDSS + s * 32 + (lane >> 4) * 8]);
          acc[t] = __builtin_amdgcn_mfma_f32_16x16x32_bf16(af, bfr, acc[t], 0, 0, 0);
        }
      }
#pragma unroll
      for (int tc = 0; tc < 4; ++tc)
#pragma unroll
        for (int reg = 0; reg < 4; ++reg) {
          const int tl = wid * 16 + (lane >> 4) * 4 + reg;
          const int c = 16 * tc + (lane & 15);
          const float r = __builtin_amdgcn_rcpf(1.f + __builtin_amdgcn_exp2f(acc[tc][reg] + ba[tc]));
          const float ii = __builtin_amdgcn_rcpf(1.f + __builtin_amdgcn_exp2f(acc[tc + 4][reg] + bi[tc]));
          const float la = -c8[tc] * r;
          const float a = __builtin_amdgcn_exp2f(la);
          const float ucv = bf2f(sm_uc[(sb * 64 + tl) * LDSS + c]);
          const float bt = __builtin_amdgcn_sqrtf(fmaxf(1.f - a * a, 0.f)) * (ii * ucv);
          sm_a[tl * 64 + c] = a;
          sm_b[tl * 64 + c] = bt;
        }
      __syncthreads();
      const int pos = (d == 0) ? q : 3 - q;
      {
        float Pp = 1.f, H = 0.f;
#pragma unroll 4
        for (int i = 0; i < 16; ++i) {
          const int tl = (d == 0) ? (q * 16 + i) : (q * 16 + 15 - i);
          const float a = sm_a[tl * 64 + ch], b = sm_b[tl * 64 + ch];
          H = a * H + b; Pp *= a;
        }
        sm_ph[pos * 64 + ch] = make_float2(Pp, H);
      }
      __syncthreads();
      const float2 p0 = sm_ph[ch], p1 = sm_ph[64 + ch], p2 = sm_ph[128 + ch], p3 = sm_ph[192 + ch];
      if (pass == 2) {
        float hin = cB;
        if (pos > 0) hin = p0.x * hin + p0.y;
        if (pos > 1) hin = p1.x * hin + p1.y;
        if (pos > 2) hin = p2.x * hin + p2.y;
        float h = hin;
        float hfp[16], gp[16];
        if (d == 1) {
#pragma unroll
          for (int i = 0; i < 16; ++i) {
            const long rowp = row0 + sb * 64 + q * 16 + 15 - i;
            hfp[i] = hfbuf[rowp * 512 + gch];
            gp[i] = bf2f(P.zq[rowp * 1536 + 512 + gch]);
          }
        }
#pragma unroll
        for (int i = 0; i < 16; ++i) {
          const int tl = (d == 0) ? (q * 16 + i) : (q * 16 + 15 - i);
          const float a = sm_a[tl * 64 + ch], b = sm_b[tl * 64 + ch];
          h = a * h + b;
          const long row = row0 + sb * 64 + tl;
          if (d == 0) {
            hfw[row * 512 + gch] = h;
          } else {
            const float hfv = hfp[i];
            const float g = gp[i];
            const float tz = 0.7978845608028654f * (g + 0.044715f * g * g * g);
            const float th = 1.f - 2.f * __builtin_amdgcn_rcpf(1.f + __expf(2.f * tz));
            const float ge = 0.5f * g * (1.f + th);
            P.cat[row * 1024 + gch] = f2bf((hfv + h) * ge);
          }
        }
      }
      cB = p0.x * cB + p0.y; cA *= p0.x;
      cB = p1.x * cB + p1.y; cA *= p1.x;
      cB = p2.x * cB + p2.y; cA *= p2.x;
      cB = p3.x * cB + p3.y; cA *= p3.x;
      __syncthreads();
    }
    if (pass == 1 && q == 0) P.summ[((long)d * 264 + chunk) * 512 + gch] = make_float2(cA, cB);
  }
}

__device__ __forceinline__ void attn_phase(const Params& P, char* smem_raw) {
  u16* sm_k = reinterpret_cast<u16*>(smem_raw);
  u16* sm_vt = sm_k + 128 * LDSS;
  u16* sm_p = sm_vt + 64 * 136;
  float* sm_rpb = reinterpret_cast<float*>(sm_p + 4 * 16 * 136);
  const int tid = VTID, lane = tid & 63, wid = tid >> 6;
  const u16* QKV = P.zq;
  const u16* VTX = P.zf;
  const u16* VTC = reinterpret_cast<const u16*>(P.summ);
  uint4 kreg[4], vreg[4];
  bf16x8 qn[2];
#define ATT_ISSUE(TT, CK)                                                                         \
  {                                                                                               \
    const int h_ = (TT) & 15, r_ = ((TT) >> 4) & 127, b_ = (TT) >> 11;                            \
    const int rs_ = min(max(r_ - 4, 0), 120);                                                     \
    const long krow0_ = ((CK) < 4) ? ((long)b_ * 8192 + rs_ * 64 + (CK) * 128)                    \
                                   : ((long)N_X + b_ * 256 + ((CK) - 4) * 128);                   \
    const u16* ksrc_ = QKV + krow0_ * 3072 + 1024 + h_ * 64;                                      \
    const u16* vsrc_ = ((CK) < 4) ? (VTX + ((long)(b_ * 16 + h_) * 64) * 8192 + rs_ * 64 + (CK) * 128) \
                                  : (VTC + ((long)(b_ * 16 + h_) * 64) * 256 + ((CK) - 4) * 128); \
    const unsigned vstride_ = ((CK) < 4) ? 8192u : 256u;                                          \
    _Pragma("unroll") for (int i = 0; i < 4; ++i) {                                               \
      const int idx = tid + 256 * i;                                                              \
      kreg[i] = ldg16(ksrc_ + (unsigned)((idx >> 3) * 3072 + (idx & 7) * 8));                     \
      vreg[i] = ldg16(vsrc_ + (unsigned)((idx >> 4) * vstride_ + (idx & 15) * 8));                \
    }                                                                                             \
  }
#define ATT_QLOAD(TT)                                                                             \
  {                                                                                               \
    const int h_ = (TT) & 15, r_ = ((TT) >> 4) & 127, b_ = (TT) >> 11;                            \
    const long qrow_ = (long)b_ * 8192 + r_ * 64 + wid * 16 + (lane & 15);                        \
    _Pragma("unroll") for (int s = 0; s < 2; ++s)                                                 \
      qn[s] = *reinterpret_cast<const bf16x8*>(QKV + qrow_ * 3072 + h_ * 64 + s * 32 + (lane >> 4) * 8); \
  }
  int dco[4][4];
#pragma unroll
  for (int reg = 0; reg < 4; ++reg) {
    const int c = wid * 16 + (lane >> 4) * 4 + reg;
    const int cs = min(max(c - 8, 0), 48);
#pragma unroll
    for (int q4 = 0; q4 < 4; ++q4) {
      const int kc = q4 * 16 + (lane & 15);
      dco[reg][q4] = (kc >= cs && kc < cs + 16) ? (kc - c + 15) : 465;
    }
  }
  int t = VBID;
  __syncthreads();
  if (t < 8192) {
    const int h0 = t & 15;
    for (int idx = tid; idx < 930; idx += VTHR) sm_rpb[idx] = (idx < 465) ? P.rpb[h0 * 465 + idx] * 1.4426950408889634f : -1e30f;
    ATT_ISSUE(t, 0)
    ATT_QLOAD(t)
  }
  for (; t < 8192; t += VGRID) {
    const int h = t & 15, r = (t >> 4) & 127, b = t >> 11;
    const int rs = min(max(r - 4, 0), 120);
    bf16x8 qf[2];
    qf[0] = qn[0]; qf[1] = qn[1];
    f32x4 o[4];
#pragma unroll
    for (int td = 0; td < 4; ++td) o[td] = f32x4{0.f, 0.f, 0.f, 0.f};
    float mrow[4], lrow[4];
#pragma unroll
    for (int reg = 0; reg < 4; ++reg) { mrow[reg] = -1e30f; lrow[reg] = 0.f; }
    for (int ck = 0; ck < 6; ++ck) {
      int lane_c = lane;
      asm volatile("" : "+v"(lane_c));
      __syncthreads();
#pragma unroll
      for (int i = 0; i < 4; ++i) {
        const int idx = tid + 256 * i;
        *reinterpret_cast<uint4*>(&sm_k[(idx >> 3) * LDSS + (idx & 7) * 8]) = kreg[i];
        *reinterpret_cast<uint4*>(&sm_vt[(idx >> 4) * 136 + (idx & 15) * 8]) = vreg[i];
      }
      __syncthreads();
      f32x4 sacc[8];
#pragma unroll
      for (int t8 = 0; t8 < 8; ++t8) sacc[t8] = f32x4{0.f, 0.f, 0.f, 0.f};
#pragma unroll
      for (int s = 0; s < 2; ++s)
#pragma unroll
        for (int t8 = 0; t8 < 8; ++t8) {
          const bf16x8 kf = *reinterpret_cast<const bf16x8*>(&sm_k[(t8 * 16 + (lane_c & 15)) * LDSS + s * 32 + (lane_c >> 4) * 8]);
          sacc[t8] = __builtin_amdgcn_mfma_f32_16x16x32_bf16(qf[s], kf, sacc[t8], 0, 0, 0);
        }
      if (ck < 5) {
        ATT_ISSUE(t, ck + 1)
      } else if (t + VGRID < 8192) {
        ATT_ISSUE(t + VGRID, 0)
        ATT_QLOAD(t + VGRID)
      }
      if (ck < 4) {
        const float* rb0 = sm_rpb + (rs + ck * 2 - r + 7) * 31;
#pragma unroll
        for (int t8 = 0; t8 < 8; ++t8)
#pragma unroll
          for (int reg = 0; reg < 4; ++reg)
            sacc[t8][reg] += rb0[(t8 >> 2) * 31 + dco[reg][t8 & 3]];
      }
#pragma unroll
      for (int reg = 0; reg < 4; ++reg) {
        float mx = sacc[0][reg];
#pragma unroll
        for (int t8 = 1; t8 < 8; ++t8) mx = fmaxf(mx, sacc[t8][reg]);
        mx = row16_max(mx);
        const float mnew = fmaxf(mrow[reg], mx);
        const float alpha = __builtin_amdgcn_exp2f(mrow[reg] - mnew);
        mrow[reg] = mnew;
        float rsum = 0.f;
#pragma unroll
        for (int t8 = 0; t8 < 8; ++t8) {
          const float p = __builtin_amdgcn_exp2f(sacc[t8][reg] - mnew);
          rsum += p;
          sm_p[(wid * 16 + (lane_c >> 4) * 4 + reg) * 136 + t8 * 16 + (lane_c & 15)] = f2bf(p);
        }
        rsum = row16_sum(rsum);
        lrow[reg] = lrow[reg] * alpha + rsum;
#pragma unroll
        for (int td = 0; td < 4; ++td) o[td][reg] *= alpha;
      }
      __syncthreads();
#pragma unroll
      for (int s4 = 0; s4 < 4; ++s4) {
        const bf16x8 pf = *reinterpret_cast<const bf16x8*>(&sm_p[(wid * 16 + (lane_c & 15)) * 136 + s4 * 32 + (lane_c >> 4) * 8]);
#pragma unroll
        for (int td = 0; td < 4; ++td) {
          const bf16x8 vf = *reinterpret_cast<const bf16x8*>(&sm_vt[(td * 16 + (lane_c & 15)) * 136 + s4 * 32 + (lane_c >> 4) * 8]);
          o[td] = __builtin_amdgcn_mfma_f32_16x16x32_bf16(pf, vf, o[td], 0, 0, 0);
        }
      }
    }
    u16* Ob = P.cat + ((long)b * 8192 + r * 64) * 1024 + h * 64;
#pragma unroll
    for (int td = 0; td < 4; ++td)
#pragma unroll
      for (int reg = 0; reg < 4; ++reg) {
        const int rowl = wid * 16 + (lane >> 4) * 4 + reg;
        Ob[(unsigned)(rowl * 1024 + td * 16 + (lane & 15))] = f2bf(o[td][reg] * __builtin_amdgcn_rcpf(lrow[reg]));
      }
  }
#undef ATT_ISSUE
#undef ATT_QLOAD
}

__device__ __forceinline__ void fourier_stepA_tile(const Params& P, int t, u16* smem) {
  const int mt = t >> 3, grp = t & 7;
  const u16* Ab = P.zq + (long)mt * 128 * 1536 + 1024 + grp * 64;
  const u16* Bb = P.d64t;
  auto al = [=](int r, int k) { return ldg16(Ab + (unsigned)(r * 1536 + k)); };
  auto bl = [=](int r, int k) { return ldg16(Bb + r * 64 + k); };
  f32x16 acc[2][2];
  gemm_tile<false>(al, bl, 64, smem, acc);
  u16* G = P.zq + (long)N_TOK * 1536 + (long)mt * 128 * 1024 + grp * 64;
  ACC_FOREACH({ G[(unsigned)(row * 1024 + (col >> 6) * 512 + (col & 63))] = f2bf(v); })
}
__device__ __forceinline__ void nn_phase(const Params& P, int set, u16* smem) {
  const int nT = (set == 0) ? 2080 : 1024;
  for (int t = VBID; t < nT; t += VGRID) {
    const u16 *Ab, *Bb; u16* Cb; unsigned lda, s1, s2, e1, e2; int K;
    const u16* G = P.zq + (long)N_TOK * 1536;
    const int nt = t & 3;
    if (set == 0 && t < 2048) {
      const int bt = t >> 2, t2 = bt & 127, b = bt >> 7;
      Ab = P.sbm + (long)t2 * 128 * 128; lda = 128; K = 128;
      Bb = G + ((long)b * 8192 + t2) * 1024 + nt * 128; s1 = 512; s2 = 128 * 1024;
      Cb = P.zf + (long)b * 64 * 256 * 512 + (long)t2 * 512 + nt * 128; e1 = 128 * 512; e2 = 256 * 512;
    } else if (set == 0) {
      const int tt = t - 2048, mt = (tt >> 2) & 1, b = tt >> 3;
      Ab = P.sxm + (long)mt * 128 * 512; lda = 512; K = 512;
      Bb = G + ((long)N_X + b * 256) * 1024 + nt * 128; s1 = 512; s2 = 1024;
      Cb = P.cat + ((long)N_X + b * 256 + mt * 128) * 1024 + 512 + nt * 128; e1 = 1024; e2 = 2048;
    } else {
      const int bk = t >> 2, k1 = bk & 63, b = bk >> 6;
      Ab = P.scm; lda = 256; K = 256;
      Bb = P.zf + ((long)b * 64 + k1) * 256 * 512 + nt * 128; s1 = 512; s2 = 1024;
      Cb = P.cat + ((long)b * 8192 + k1) * 1024 + 512 + nt * 128; e1 = 64 * 1024; e2 = 128 * 1024;
    }
    auto al = [=](int r, int k) { return ldg16(Ab + (unsigned)(r * lda + k)); };
    auto bl = [=](int n, int k) { return gather8p(Bb, (unsigned)((k >> 1) * s2 + n), s1, s2); };
    f32x16 acc[2][2];
    gemm_tile_nn<true>(al, bl, K, smem, acc);
    ACC_FOREACH({ Cb[(unsigned)((row >> 1) * e2 + (row & 1) * e1 + col)] = f2bf(v); })
  }
}

#define XB_TMO      128
#define XB_XCNT(j)  (256  + 64 * (j))
#define XB_XSUB(j)  (1280 + 64 * (j))
#define XB_XGEN(j)  (2304 + 64 * (j))
#define XB_TOP      3328
#define XB_TOPGEN   3392
#define XCD_BAR_WORDS 3456
#define XB_SPIN_CAP (1u << 18)
#define LAS __attribute__((address_space(3)))

__device__ __forceinline__ unsigned xb_ld(unsigned* p)              { return __hip_atomic_load(p, __ATOMIC_RELAXED, __HIP_MEMORY_SCOPE_AGENT); }
__device__ __forceinline__ unsigned xb_add(unsigned* p, unsigned v) { return __hip_atomic_fetch_add(p, v, __ATOMIC_RELAXED, __HIP_MEMORY_SCOPE_AGENT); }
__device__ __forceinline__ unsigned xb_xcc_id() { return (unsigned)__builtin_amdgcn_s_getreg((3 << 11) | 20) & 0xFu; }
#define XB_SPIN(cond, bar) do { unsigned _sp = 0; while (cond) { __builtin_amdgcn_s_sleep(1); \
    if ((++_sp & 255u) == 0u) { if (xb_ld(&(bar)[XB_TMO])) break; if (_sp > XB_SPIN_CAP) { atomicAdd(&(bar)[XB_TMO], 1u); break; } } } } while (0)

struct XcdBarrier {
    unsigned* bar; unsigned x;
    volatile LAS unsigned* st;
};

__device__ __forceinline__ XcdBarrier xcd_barrier_post(unsigned* bar, volatile LAS unsigned* st) {
    XcdBarrier b; b.bar = bar; b.x = xb_xcc_id(); b.st = st;
    if (threadIdx.x == 0) (void)xb_add(&bar[XB_XCNT(b.x)], 1u);
    return b;
}
__device__ __forceinline__ void xcd_barrier_complete(unsigned* bar, unsigned x, unsigned& nloc, unsigned& nx) {
    const unsigned G = gridDim.x * gridDim.y * gridDim.z;
    unsigned sum, cnt, mine, sp = 0u;
    for (;;) {
        sum = 0u; cnt = 0u; mine = 0u;
#pragma unroll
        for (unsigned j = 0; j < 16; ++j) { const unsigned c = xb_ld(&bar[XB_XCNT(j)]); sum += c; cnt += (c > 0u) ? 1u : 0u; mine = (j == x) ? c : mine; }
        if (sum == G) break;
        __builtin_amdgcn_s_sleep(1);
        if ((++sp & 255u) == 0u) { if (xb_ld(&bar[XB_TMO])) break; if (sp > XB_SPIN_CAP) { atomicAdd(&bar[XB_TMO], 1u); break; } }
    }
    nloc = mine > 0u ? mine : 1u; nx = cnt > 0u ? cnt : 1u;
}

__device__ __forceinline__ void xcd_barrier(const XcdBarrier& b) {
    asm volatile("s_waitcnt vmcnt(0)" ::: "memory");
    __syncthreads();
    if (threadIdx.x == 0) {
        unsigned* bar = b.bar;
        __builtin_amdgcn_s_waitcnt(0);
        unsigned nloc = b.st[0], nx = b.st[1];
        if (nloc == 0u) { xcd_barrier_complete(bar, b.x, nloc, nx); b.st[0] = nloc; b.st[1] = nx; }
        const unsigned old = xb_add(&bar[XB_XSUB(b.x)], 1u);
        const unsigned gen = old / nloc;
        if (old + 1u == (gen + 1u) * nloc) {
            __builtin_amdgcn_fence(__ATOMIC_RELEASE, "agent");
            asm volatile("s_waitcnt vmcnt(0)" ::: "memory");
            const unsigned og = xb_add(&bar[XB_TOP], 1u);
            const unsigned tg = og / nx;
            if (og + 1u == (tg + 1u) * nx) xb_add(&bar[XB_TOPGEN], 1u);
            else XB_SPIN(xb_ld(&bar[XB_TOPGEN]) == tg, bar);
            __builtin_amdgcn_fence(__ATOMIC_ACQUIRE, "agent");
            xb_add(&bar[XB_XGEN(b.x)], 1u);
            asm volatile("s_waitcnt vmcnt(0)" ::: "memory");
        } else {
            XB_SPIN(xb_ld(&bar[XB_XGEN(b.x)]) == gen, bar);
            __builtin_amdgcn_fence(__ATOMIC_ACQUIRE, "agent");
            asm volatile("s_waitcnt vmcnt(0)" ::: "memory");
        }
    }
    __syncthreads();
}


#define NPHASE 18
__device__ __forceinline__ void run_phase(const Params& P, const int ph, char* smem_raw) {
  u16* smem = reinterpret_cast<u16*>(smem_raw);
  int vb_ = threadIdx.x >> 8;
  asm volatile("" : "+v"(vb_));
  char* smv_raw = smem_raw + vb_ * SMEM_V;
  u16* smv = reinterpret_cast<u16*>(smv_raw);
#ifdef ONLY_PHASE
  if (ph != ONLY_PHASE) return;
#endif
  switch (ph) {
    case 0: prep_phase(P, reinterpret_cast<float*>(smv_raw)); break;
    case 1: row_phase(P, 0, 0, 0, false, 0, nullptr, 0, true, P.g_pre_mix, 0, N_TOK); break;
    case 2: gemm_nt_phase(P.hy, 1024, P.wt_in, 1024, P.zq, 1536, 132, 6, 1024, 0, 1.f, smem, nullptr, nullptr, smv); break;
    case 3:
      for (int t = VBID; t < 2112; t += VGRID) lru_tile(P, t >> 3, t & 7, 1, smv_raw);
      for (int t = VBID; t < 2112; t += VGRID) fourier_stepA_tile(P, t, smv);
      break;
    case 4:
      for (int t = VBID; t < 2112; t += VGRID) lru_tile(P, t >> 3, t & 7, 2, smv_raw);
      nn_phase(P, 0, smv);
      break;
    case 5: nn_phase(P, 1, smv); break;
    case 6: gemm_nt_phase(P.cat, 1024, P.wt_outab, 1024, P.hy, 1024, 132, 4, 1024, 0, 1.f, smem, nullptr, nullptr, smv); break;
    case 7: row_phase(P, 0, 0, 0, true, 2, P.g_post_mix, 1, true, P.g_pre_ffn, 3, N_TOK); break;
    case 8: gemm_swiglu_phase(P.hy, P.wt_gu, P.zq, 132, smem, smv); break;
    case 9: gemm_nt_phase(P.zq, 2816, P.wt_dn, 2816, P.hy, 1024, 132, 4, 2816, 0, 1.f, smem, nullptr, nullptr, smv); break;
    case 10: row_phase(P, 0, 1, 1, true, 5, P.g_post_ffn, 1, true, P.g_pre_mix + 1024, 0, N_TOK); break;
    case 11: gemm_nt_phase(P.hy, 1024, P.wt_qkv, 1024, P.zq, 3072, 132, 12, 1024, 1024, 0.125f * 1.4426950408889634f, smem, P.zf, reinterpret_cast<u16*>(P.summ), smv); break;
    case 12:
      attn_phase(P, smv_raw);
      break;
    case 13: gemm_nt_phase(P.cat, 1024, P.wt_outna, 1024, P.hy, 1024, 128, 4, 1024, 0, 1.f, smem); break;
    case 14: row_phase(P, 1, 1, 1, true, 2, P.g_post_mix + 1024, 2, true, P.g_pre_ffn + 1024, 3, N_X); break;
    case 15: gemm_swiglu_phase(P.hy, P.wt_gu + (long)5632 * 1024, P.zq, 128, smem); break;
    case 16: gemm_nt_phase(P.zq, 2816, P.wt_dn + (long)1024 * 2816, 2816, P.hy, 1024, 128, 4, 2816, 0, 1.f, smem); break;
    case 17: row_phase(P, 1, 1, 2, true, 5, P.g_post_ffn + 1024, 3, false, nullptr, 0, N_X); break;
    default: break;
  }
}

__global__ void __launch_bounds__(NTHR) mega_kernel(Params P, int lo, int hi) {
  extern __shared__ __attribute__((aligned(16))) char smem_raw[];
  __shared__ uint4 xb_words;
  cg::grid_group grid = cg::this_grid();
  if (threadIdx.x == 0) xb_words = make_uint4(0u, 0u, 0u, 0u);
  if (blockIdx.x == 0) for (int i = threadIdx.x; i < XCD_BAR_WORDS; i += NTHR) P.bar[i] = 0u;
  __syncthreads();
  if (lo <= 0 && 0 < hi) { run_phase(P, 0, smem_raw); if (1 < hi) { grid.sync(); (void)xcd_barrier_post(P.bar, (volatile LAS unsigned*)&xb_words); } }
#ifndef DUPMASK
#define DUPMASK 0
#endif
#define RUN_PH(n) if (lo <= (n) && (n) < hi) { run_phase(P, (n), smem_raw); if ((DUPMASK >> (n)) & 1) run_phase(P, (n), smem_raw); if ((n) + 1 < hi) { XcdBarrier xb_; xb_.bar = P.bar; xb_.x = xb_xcc_id(); xb_.st = (volatile LAS unsigned*)&xb_words; xcd_barrier(xb_); } }
  RUN_PH(1) RUN_PH(2) RUN_PH(3) RUN_PH(4) RUN_PH(5) RUN_PH(6) RUN_PH(7) RUN_PH(8)
  RUN_PH(9) RUN_PH(10) RUN_PH(11) RUN_PH(12) RUN_PH(13) RUN_PH(14) RUN_PH(15) RUN_PH(16) RUN_PH(17)
}

extern "C" void kernel_launch(void* const* d_in, const int* in_sizes, int n_in, void* d_out, int out_size,
                              void* d_ws, size_t ws_size, hipStream_t stream) {
  (void)in_sizes; (void)n_in; (void)out_size; (void)ws_size;
  Params p{};
  const float* const* in = reinterpret_cast<const float* const*>(d_in);
  p.x = in[0]; p.c = in[1]; p.ctx = in[2]; p.c_ctx = in[3]; p.w_mod = in[4]; p.b_mod = in[5];
  p.g_pre_mix = in[6]; p.g_post_mix = in[7]; p.g_pre_ffn = in[8]; p.g_post_ffn = in[9];
  p.w_gate = in[10]; p.w_up = in[11]; p.w_down = in[12]; p.w_in_ab = in[13]; p.conv_w = in[14]; p.conv_b = in[15];
  p.w_a = in[16]; p.b_a = in[17]; p.w_i = in[18]; p.b_i = in[19]; p.lam = in[20]; p.w_out_ab = in[21];
  p.w_qkv = in[22]; p.rpb = in[23]; p.w_out_na = in[24];
  p.out = reinterpret_cast<float*>(d_out);
  char* ws = reinterpret_cast<char*>(d_ws);
  size_t off = 0;
  auto take = [&](size_t bytes) { char* r = ws + off; off += (bytes + 255) & ~(size_t)255; return r; };
  p.wt_in = (u16*)take((size_t)1536 * 1024 * 2);
  p.wt_outab = (u16*)take((size_t)1024 * 1024 * 2);
  p.wt_qkv = (u16*)take((size_t)3072 * 1024 * 2);
  p.wt_outna = (u16*)take((size_t)1024 * 1024 * 2);
  p.wt_gu = (u16*)take((size_t)2 * 5632 * 1024 * 2);
  p.wt_dn = (u16*)take((size_t)2 * 1024 * 2816 * 2);
  p.mod = (float*)take((size_t)2 * 5 * 6144 * 4);
  p.d64t = (u16*)take((size_t)128 * 64 * 2);
  p.sbm = (u16*)take((size_t)128 * 128 * 128 * 2);
  p.scm = (u16*)take((size_t)128 * 256 * 2);
  p.sxm = (u16*)take((size_t)256 * 512 * 2);
  p.wg = (u16*)take((size_t)2 * 8 * 2 * 64 * 64 * 2);
  p.summ = (float2*)take((size_t)2 * 264 * 512 * 8);
  p.xc = (float*)take((size_t)1024 * 1024 * 4);
  p.hy = (u16*)take((size_t)N_TOK * 1024 * 2);
  p.zq = (u16*)take((size_t)N_TOK * 3072 * 2);
  p.zf = (u16*)take((size_t)4 * 64 * 256 * 512 * 2);
  p.cat = (u16*)take((size_t)N_TOK * 1024 * 2);
  p.bar = (unsigned*)take((size_t)XCD_BAR_WORDS * 4);

  static int grid_blocks = 0;
  if (!grid_blocks) {
    int dev = 0, cus = 0, per_cu = 0;
    hipGetDevice(&dev);
    hipDeviceGetAttribute(&cus, hipDeviceAttributeMultiprocessorCount, dev);
    hipFuncSetAttribute(reinterpret_cast<const void*>(mega_kernel), hipFuncAttributeMaxDynamicSharedMemorySize, SMEM_BYTES);
    hipOccupancyMaxActiveBlocksPerMultiprocessor(&per_cu, mega_kernel, NTHR, SMEM_BYTES);
    if (per_cu < 1) per_cu = 1;
    if (per_cu > 1) per_cu = 1;
    grid_blocks = cus * per_cu;
  }
#if ONE_LAUNCH
  int lo = 0, hi = NPHASE;
  void* args[] = {&p, &lo, &hi};
  hipError_t e = hipLaunchCooperativeKernel(reinterpret_cast<const void*>(mega_kernel), dim3(grid_blocks), dim3(NTHR), args,
                                            SMEM_BYTES, stream);
  if (e != hipSuccess) fprintf(stderr, "cooperative launch failed: %s (grid %d)\n", hipGetErrorString(e), grid_blocks);
#else
  for (int ph = 0; ph < NPHASE; ++ph)
    hipLaunchKernelGGL(mega_kernel, dim3(grid_blocks), dim3(NTHR), SMEM_BYTES, stream, p, ph, ph + 1);
#endif
}
```

```cpp
#include <hip/hip_runtime.h>
#include <hip/hip_cooperative_groups.h>
#include <cstdio>
namespace cg = cooperative_groups;

typedef unsigned short u16;
using bf16x8 = __attribute__((ext_vector_type(8))) short;
using f32x4  = __attribute__((ext_vector_type(4))) float;
using f32x16 = __attribute__((ext_vector_type(16))) float;

#ifndef ONE_LAUNCH
#define ONE_LAUNCH 1
#endif

#define N_TOK 33792
#define N_X   32768
#define NTHR  512
#define VTHR  256
#define VTID ((int)(threadIdx.x & 255))
#define VBID ((int)(blockIdx.x * 2 + (threadIdx.x >> 8)))
#define VGRID ((int)(gridDim.x * 2))
#define SMEM_V 73728
#define LDSS  72
#define SMEM_BYTES 147456
#define EPSF 1e-6f

struct Params {
  const float *x, *c, *ctx, *c_ctx, *w_mod, *b_mod, *g_pre_mix, *g_post_mix, *g_pre_ffn, *g_post_ffn;
  const float *w_gate, *w_up, *w_down, *w_in_ab, *conv_w, *conv_b, *w_a, *b_a, *w_i, *b_i, *lam;
  const float *w_out_ab, *w_qkv, *rpb, *w_out_na;
  float* out;
  u16 *wt_in, *wt_outab, *wt_qkv, *wt_outna, *wt_gu, *wt_dn;
  float* mod;
  u16 *d64t, *sbm, *scm, *sxm, *wg;
  float2* summ;
  float* xc;
  u16 *hy, *zq, *zf, *cat;
  unsigned* bar;
};

__device__ __forceinline__ u16 f2bf(float f) {
  const __bf16 b = static_cast<__bf16>(f);
  return __builtin_bit_cast(u16, b);
}
__device__ __forceinline__ float bf2f(u16 h) { return __uint_as_float(((unsigned)h) << 16); }
__device__ __forceinline__ uint4 ldg16(const u16* p) { return *reinterpret_cast<const uint4*>(p); }
__device__ __forceinline__ uint4 gather8(const u16* p, unsigned off, unsigned stride) {
  unsigned v0 = p[off], v1 = p[off + stride], v2 = p[off + 2 * stride], v3 = p[off + 3 * stride];
  unsigned v4 = p[off + 4 * stride], v5 = p[off + 5 * stride], v6 = p[off + 6 * stride], v7 = p[off + 7 * stride];
  return make_uint4(v0 | (v1 << 16), v2 | (v3 << 16), v4 | (v5 << 16), v6 | (v7 << 16));
}
__device__ __forceinline__ uint4 gather8p(const u16* p, unsigned off, unsigned s1, unsigned s2) {
  unsigned v0 = p[off], v1 = p[off + s1], v2 = p[off + s2], v3 = p[off + s2 + s1];
  unsigned v4 = p[off + 2 * s2], v5 = p[off + 2 * s2 + s1], v6 = p[off + 3 * s2], v7 = p[off + 3 * s2 + s1];
  return make_uint4(v0 | (v1 << 16), v2 | (v3 << 16), v4 | (v5 << 16), v6 | (v7 << 16));
}
__device__ __forceinline__ float sigmoidf_(float x) { return __builtin_amdgcn_rcpf(1.f + __expf(-x)); }
template <int CTRL>
__device__ __forceinline__ float dpp_mov(float v) {
  return __int_as_float(__builtin_amdgcn_update_dpp(0, __float_as_int(v), CTRL, 0xF, 0xF, true));
}
__device__ __forceinline__ float row16_max(float v) {
  v = fmaxf(v, dpp_mov<0xB1>(v)); v = fmaxf(v, dpp_mov<0x4E>(v));
  v = fmaxf(v, dpp_mov<0x141>(v)); v = fmaxf(v, dpp_mov<0x140>(v));
  return v;
}
__device__ __forceinline__ float row16_sum(float v) {
  v += dpp_mov<0xB1>(v); v += dpp_mov<0x4E>(v);
  v += dpp_mov<0x141>(v); v += dpp_mov<0x140>(v);
  return v;
}
__device__ __forceinline__ float wave_sum(float v) {
#pragma unroll
  for (int o = 32; o > 0; o >>= 1) v += __shfl_xor(v, o);
  return v;
}

template <bool BNN, class AL, class BL>
__device__ __forceinline__ void gemm_tile_nn(const AL& al, const BL& bl, int K, u16* smem, f32x16 (&acc)[2][2]) {
  const int tid = VTID, lane = tid & 63, wid = tid >> 6;
  const int wm = wid >> 1, wn = wid & 1;
  u16* sA = smem;
  u16* sB = smem + 2 * 128 * LDSS;
#pragma unroll
  for (int i = 0; i < 2; ++i)
#pragma unroll
    for (int j = 0; j < 2; ++j)
#pragma unroll
      for (int r = 0; r < 16; ++r) acc[i][j][r] = 0.f;
  uint4 ra[4], rb[4];
  const int lr = tid >> 3, lk = (tid & 7) * 8;
  const int nr = tid & 127, nk = (tid >> 7) * 8;
  const int nkt = K >> 6;
#pragma unroll
  for (int i = 0; i < 4; ++i) {
    ra[i] = al(lr + 32 * i, lk);
    if (BNN) rb[i] = bl(nr, nk + 16 * i); else rb[i] = bl(lr + 32 * i, lk);
  }
#pragma unroll
  for (int i = 0; i < 4; ++i) {
    *reinterpret_cast<uint4*>(&sA[(lr + 32 * i) * LDSS + lk]) = ra[i];
    if (BNN) *reinterpret_cast<uint4*>(&sB[nr * LDSS + nk + 16 * i]) = rb[i];
    else     *reinterpret_cast<uint4*>(&sB[(lr + 32 * i) * LDSS + lk]) = rb[i];
  }
  __syncthreads();
  for (int kt = 0; kt < nkt; ++kt) {
    const bool more = (kt + 1 < nkt);
    if (more) {
      const int k0 = (kt + 1) << 6;
#pragma unroll
      for (int i = 0; i < 4; ++i) {
        ra[i] = al(lr + 32 * i, k0 + lk);
        if (BNN) rb[i] = bl(nr, k0 + nk + 16 * i); else rb[i] = bl(lr + 32 * i, k0 + lk);
      }
    }
    const u16* a = sA + (kt & 1) * 128 * LDSS;
    const u16* b = sB + (kt & 1) * 128 * LDSS;
#pragma unroll
    for (int s = 0; s < 4; ++s) {
      bf16x8 af[2], bfr[2];
#pragma unroll
      for (int i = 0; i < 2; ++i)
        af[i] = *reinterpret_cast<const bf16x8*>(&a[(wm * 64 + i * 32 + (lane & 31)) * LDSS + s * 16 + (lane >> 5) * 8]);
#pragma unroll
      for (int j = 0; j < 2; ++j)
        bfr[j] = *reinterpret_cast<const bf16x8*>(&b[(wn * 64 + j * 32 + (lane & 31)) * LDSS + s * 16 + (lane >> 5) * 8]);
#pragma unroll
      for (int i = 0; i < 2; ++i)
#pragma unroll
        for (int j = 0; j < 2; ++j)
          acc[i][j] = __builtin_amdgcn_mfma_f32_32x32x16_bf16(af[i], bfr[j], acc[i][j], 0, 0, 0);
    }
    if (more) {
      u16* a2 = sA + ((kt + 1) & 1) * 128 * LDSS;
      u16* b2 = sB + ((kt + 1) & 1) * 128 * LDSS;
#pragma unroll
      for (int i = 0; i < 4; ++i) {
        *reinterpret_cast<uint4*>(&a2[(lr + 32 * i) * LDSS + lk]) = ra[i];
        if (BNN) *reinterpret_cast<uint4*>(&b2[nr * LDSS + nk + 16 * i]) = rb[i];
        else     *reinterpret_cast<uint4*>(&b2[(lr + 32 * i) * LDSS + lk]) = rb[i];
      }
    }
    __syncthreads();
  }
}

template <bool BNN, class AL, class BL>
__device__ __forceinline__ void gemm_tile(const AL& al, const BL& bl, int K, u16* smem, f32x16 (&acc)[2][2]) {
  const int tid = VTID, lane = tid & 63, wid = tid >> 6;
  const int wm = wid >> 1, wn = wid & 1;
  u16* sA = smem;
  u16* sB = smem + 2 * 128 * LDSS;
#pragma unroll
  for (int i = 0; i < 2; ++i)
#pragma unroll
    for (int j = 0; j < 2; ++j)
#pragma unroll
      for (int r = 0; r < 16; ++r) acc[i][j][r] = 0.f;
  uint4 ra0[4], rb0[4], ra1[4], rb1[4];
  const int lr = tid >> 3, lk = (tid & 7) * 8;
  const int nr = tid & 127, nk = (tid >> 7) * 8;
  const int nkt = K >> 6;
#define G_LOAD(RA, RB, KT)                                                          \
  {                                                                                 \
    const int k0_ = (KT) << 6;                                                      \
    _Pragma("unroll") for (int i = 0; i < 4; ++i) {                                 \
      RA[i] = al(lr + 32 * i, k0_ + lk);                                            \
      if (BNN) RB[i] = bl(nr, k0_ + nk + 16 * i); else RB[i] = bl(lr + 32 * i, k0_ + lk); \
    }                                                                               \
  }
#define G_STORE(RA, RB, BUF)                                                        \
  {                                                                                 \
    u16* a2_ = sA + (BUF) * 128 * LDSS;                                             \
    u16* b2_ = sB + (BUF) * 128 * LDSS;                                             \
    _Pragma("unroll") for (int i = 0; i < 4; ++i) {                                 \
      *reinterpret_cast<uint4*>(&a2_[(lr + 32 * i) * LDSS + lk]) = RA[i];           \
      if (BNN) *reinterpret_cast<uint4*>(&b2_[nr * LDSS + nk + 16 * i]) = RB[i];    \
      else     *reinterpret_cast<uint4*>(&b2_[(lr + 32 * i) * LDSS + lk]) = RB[i];  \
    }                                                                               \
  }
#define G_FRAGS(AF, BF, S)                                                          \
  {                                                                                 \
    _Pragma("unroll") for (int i = 0; i < 2; ++i)                                   \
      AF[i] = *reinterpret_cast<const bf16x8*>(&a_[(wm * 64 + i * 32 + (lane & 31)) * LDSS + (S) * 16 + (lane >> 5) * 8]); \
    _Pragma("unroll") for (int j = 0; j < 2; ++j)                                   \
      BF[j] = *reinterpret_cast<const bf16x8*>(&b_[(wn * 64 + j * 32 + (lane & 31)) * LDSS + (S) * 16 + (lane >> 5) * 8]); \
  }
#define G_MMA(AF, BF)                                                               \
  {                                                                                 \
    _Pragma("unroll") for (int i = 0; i < 2; ++i)                                   \
    _Pragma("unroll") for (int j = 0; j < 2; ++j)                                   \
      acc[i][j] = __builtin_amdgcn_mfma_f32_32x32x16_bf16(AF[i], BF[j], acc[i][j], 0, 0, 0); \
  }
#define G_COMPUTE(BUF)                                                              \
  {                                                                                 \
    const u16* a_ = sA + (BUF) * 128 * LDSS;                                        \
    const u16* b_ = sB + (BUF) * 128 * LDSS;                                        \
    bf16x8 afA[2], bfA[2], afB[2], bfB[2];                                          \
    G_FRAGS(afA, bfA, 0)                                                            \
    G_FRAGS(afB, bfB, 1)                                                            \
    G_MMA(afA, bfA)                                                                 \
    __builtin_amdgcn_sched_barrier(0);                                              \
    G_FRAGS(afA, bfA, 2)                                                            \
    G_MMA(afB, bfB)                                                                 \
    __builtin_amdgcn_sched_barrier(0);                                              \
    G_FRAGS(afB, bfB, 3)                                                            \
    G_MMA(afA, bfA)                                                                 \
    __builtin_amdgcn_sched_barrier(0);                                              \
    G_MMA(afB, bfB)                                                                 \
  }
  G_LOAD(ra0, rb0, 0)
  G_STORE(ra0, rb0, 0)
  if (nkt > 1) G_LOAD(ra1, rb1, 1)
  __syncthreads();
  for (int kt = 0; kt < nkt; kt += 2) {
    if (kt + 2 < nkt) G_LOAD(ra0, rb0, kt + 2)
    G_COMPUTE(0)
    if (kt + 1 < nkt) G_STORE(ra1, rb1, 1)
    __syncthreads();
    if (kt + 1 >= nkt) break;
    if (kt + 3 < nkt) G_LOAD(ra1, rb1, kt + 3)
    G_COMPUTE(1)
    if (kt + 2 < nkt) G_STORE(ra0, rb0, 0)
    __syncthreads();
  }
#undef G_LOAD
#undef G_STORE
#undef G_COMPUTE
#undef G_FRAGS
#undef G_MMA
}

#define ACC_FOREACH(BODY)                                                          \
  {                                                                                \
    int tid_ = VTID;                                                               \
    asm volatile("" : "+v"(tid_));                                                 \
    const int lane_ = tid_ & 63, wid_ = tid_ >> 6;                                 \
    const int wm_ = wid_ >> 1, wn_ = wid_ & 1;                                     \
    _Pragma("unroll") for (int i_ = 0; i_ < 2; ++i_)                               \
    _Pragma("unroll") for (int j_ = 0; j_ < 2; ++j_)                               \
    _Pragma("unroll") for (int r_ = 0; r_ < 16; ++r_) {                            \
      const int row = wm_ * 64 + i_ * 32 + (r_ & 3) + 8 * (r_ >> 2) + 4 * (lane_ >> 5); \
      const int col = wn_ * 64 + j_ * 32 + (lane_ & 31);                           \
      const float v = acc[i_][j_][r_];                                             \
      BODY                                                                         \
    }                                                                              \
  }

#define LAS3 __attribute__((address_space(3)))
__device__ __forceinline__ void glds16(const u16* g, char* l) {
  __builtin_amdgcn_global_load_lds((const unsigned*)g, (LAS3 unsigned*)l, 16, 0, 0);
}
__device__ __forceinline__ void gemm256_tile(const u16* Ab, int lda, const u16* Bb, int ldb, int K, char* smem,
                                             f32x16 (&acc)[2][4]) {
  const int tid = threadIdx.x, lane = tid & 63, wid = tid >> 6;
  const int wm = wid >> 1, wn = wid & 1;
#pragma unroll
  for (int i = 0; i < 2; ++i)
#pragma unroll
    for (int j = 0; j < 4; ++j)
#pragma unroll
      for (int r = 0; r < 16; ++r) acc[i][j][r] = 0.f;
  int nks = K >> 5;
  asm volatile("" : "+s"(nks));
  const int drow = wid * 16 + (lane >> 2);
  const int dk = ((lane & 3) ^ ((lane >> 4) & 3)) * 8;
  const unsigned ga0 = (unsigned)(drow * lda + dk), ga1 = (unsigned)((drow + 128) * lda + dk);
  const unsigned gb0 = (unsigned)(drow * ldb + dk), gb1 = (unsigned)((drow + 128) * ldb + dk);
  const unsigned dl0 = (unsigned)((wid * 64 + lane) * 16), dl1 = (unsigned)(((8 + wid) * 64 + lane) * 16);
#define DMA_STAGE(S)                                                     \
  {                                                                      \
    const int k0_ = (S) << 5;                                            \
    char* sb_ = smem + ((S) & 3) * 32768;                                \
    glds16(Ab + ga0 + k0_, sb_ + dl0);                                   \
    glds16(Ab + ga1 + k0_, sb_ + dl1);                                   \
    glds16(Bb + gb0 + k0_, sb_ + 16384 + dl0);                           \
    glds16(Bb + gb1 + k0_, sb_ + 16384 + dl1);                           \
  }
  const int xsw = (lane >> 2) & 3, hh = lane >> 5;
  const unsigned fo0 = (unsigned)((hh ^ xsw) * 16), fo1 = (unsigned)(((2 + hh) ^ xsw) * 16);
  const unsigned fa = (unsigned)((wm * 64 + (lane & 31)) * 64);
  const unsigned fb = (unsigned)(16384 + (wn * 128 + (lane & 31)) * 64);
#define G_FRAGS(AF, BF, Q, FO)                                                                       \
  {                                                                                                  \
    const char* sb_ = smem + (Q) * 32768;                                                            \
    _Pragma("unroll") for (int i = 0; i < 2; ++i)                                                    \
      AF[i] = *reinterpret_cast<const bf16x8*>(sb_ + fa + i * 2048 + FO);                            \
    _Pragma("unroll") for (int j = 0; j < 4; ++j)                                                    \
      BF[j] = *reinterpret_cast<const bf16x8*>(sb_ + fb + j * 2048 + FO);                            \
  }
#define G_MMA(AF, BF)                                                               \
  {                                                                                 \
    __builtin_amdgcn_s_setprio(1);                                                  \
    _Pragma("unroll") for (int i = 0; i < 2; ++i)                                   \
    _Pragma("unroll") for (int j = 0; j < 4; ++j)                                   \
      acc[i][j] = __builtin_amdgcn_mfma_f32_32x32x16_bf16(AF[i], BF[j], acc[i][j], 0, 0, 0); \
    __builtin_amdgcn_s_setprio(0);                                                  \
  }
#define G_WAIT_BAR(S)                                                                              \
  {                                                                                                \
    if ((S) + 3 < nks)      asm volatile("s_waitcnt vmcnt(8) lgkmcnt(0)\n\ts_barrier" ::: "memory"); \
    else if ((S) + 2 < nks) asm volatile("s_waitcnt vmcnt(4) lgkmcnt(0)\n\ts_barrier" ::: "memory"); \
    else                    asm volatile("s_waitcnt vmcnt(0) lgkmcnt(0)\n\ts_barrier" ::: "memory"); \
  }
  asm volatile("s_waitcnt vmcnt(0)" ::: "memory");
  const bool h1 = __builtin_amdgcn_readfirstlane(wid) >= 4;
#define LGKM0_BAR asm volatile("s_waitcnt lgkmcnt(0)\n\ts_barrier" ::: "memory");
  DMA_STAGE(0)
  if (nks > 1) DMA_STAGE(1)
  if (nks > 2) DMA_STAGE(2)
  if (nks > 3) DMA_STAGE(3)
  if (nks > 3)      asm volatile("s_waitcnt vmcnt(12)\n\ts_barrier" ::: "memory");
  else if (nks > 2) asm volatile("s_waitcnt vmcnt(8)\n\ts_barrier" ::: "memory");
  else if (nks > 1) asm volatile("s_waitcnt vmcnt(4)\n\ts_barrier" ::: "memory");
  else              asm volatile("s_waitcnt vmcnt(0)\n\ts_barrier" ::: "memory");
  bf16x8 afA[2], bfA[4], afB[2], bfB[4];
  if (!h1) {
    G_FRAGS(afA, bfA, 0, fo0)
    LGKM0_BAR
    for (int s = 0; s < nks; ++s) {
      const int q = s & 3;
      G_MMA(afA, bfA)
      __builtin_amdgcn_sched_barrier(0);
      LGKM0_BAR
      G_FRAGS(afB, bfB, q, fo1)
      __builtin_amdgcn_sched_barrier(0);
      LGKM0_BAR
      G_MMA(afB, bfB)
      __builtin_amdgcn_sched_barrier(0);
      G_WAIT_BAR(s)
      if (s + 4 < nks) DMA_STAGE(s + 4)
      if (s + 1 < nks) G_FRAGS(afA, bfA, (s + 1) & 3, fo0)
      __builtin_amdgcn_sched_barrier(0);
      LGKM0_BAR
    }
  } else {
    LGKM0_BAR
    for (int s = 0; s < nks; ++s) {
      const int q = s & 3;
      G_FRAGS(afA, bfA, q, fo0)
      __builtin_amdgcn_sched_barrier(0);
      LGKM0_BAR
      G_MMA(afA, bfA)
      __builtin_amdgcn_sched_barrier(0);
      LGKM0_BAR
      G_FRAGS(afB, bfB, q, fo1)
      __builtin_amdgcn_sched_barrier(0);
      G_WAIT_BAR(s)
      G_MMA(afB, bfB)
      __builtin_amdgcn_sched_barrier(0);
      if (s + 4 < nks) DMA_STAGE(s + 4)
      __builtin_amdgcn_sched_barrier(0);
      LGKM0_BAR
    }
  }
#undef LGKM0_BAR
  __syncthreads();
#undef DMA_STAGE
#undef G_FRAGS
#undef G_MMA
#undef G_WAIT_BAR
}

__device__ __forceinline__ void tile_map256(int t, int Mt, int Nt, int& mt, int& nt) {
  const int nT = Mt * Nt;
  const int x = t & 7, w = t >> 3, q = nT >> 3, r = nT & 7;
  const int L = (x < r ? x * (q + 1) : r * (q + 1) + (x - r) * q) + w;
  const int per = 4 * Nt;
  const int grp = L / per, jj = L - grp * per;
  nt = jj >> 2;
  mt = grp * 4 + (jj & 3);
}

__device__ __forceinline__ void gemm_nt_phase(const u16* A, int lda, const u16* Bt, int ldb, u16* C, int ldc,
                              int Mt, int Nt, int K, int qcols, float qscale, u16* smem,
                              u16* vtx = nullptr, u16* vtc = nullptr, u16* smv = nullptr) {
  if (smv != nullptr) {
    const int NtS = Nt * 2, nS = 8 * NtS;
    for (int t = VBID; t < nS; t += VGRID) {
      const int ms = t / NtS, ns = t - ms * NtS;
      const u16* Ab = A + (long)(N_X + ms * 128) * lda;
      const u16* Bb = Bt + (long)ns * 128 * ldb;
      auto al = [=](int r, int k) { return ldg16(Ab + (unsigned)(r * lda + k)); };
      auto bl = [=](int r, int k) { return ldg16(Bb + (unsigned)(r * ldb + k)); };
      f32x16 acc[2][2];
      gemm_tile<false>(al, bl, K, smv, acc);
      u16* Cb = C + (long)(N_X + ms * 128) * ldc + ns * 128;
      if (vtc != nullptr && ns >= 16) {
        u16* Vb = vtc + (long)(ms >> 1) * 1024 * 256 + (long)(ns - 16) * 128 * 256 + (ms & 1) * 128;
        ACC_FOREACH({ Vb[(unsigned)(col * 256 + row)] = f2bf(v); })
      } else {
        ACC_FOREACH({ Cb[(unsigned)(row * ldc + col)] = f2bf(v); })
      }
    }
    __syncthreads();
    Mt = 128;
  }
  const int nT = Mt * Nt;
  for (int t = blockIdx.x; t < nT; t += gridDim.x) {
    int mt, nt; tile_map256(t, Mt, Nt, mt, nt);
    const u16* Ab = A + (long)mt * 256 * lda;
    const u16* Bb = Bt + (long)nt * 256 * ldb;
    f32x16 acc[2][4];
    gemm256_tile(Ab, lda, Bb, ldb, K, reinterpret_cast<char*>(smem), acc);
    u16* Cb = C + (long)mt * 256 * ldc + nt * 256;
    const float sc = (nt * 256 < qcols) ? qscale : 1.f;
    int tid_ = threadIdx.x;
    asm volatile("" : "+v"(tid_));
    const int lane = tid_ & 63, wid = tid_ >> 6, wm = wid >> 1, wn = wid & 1;
    if (vtx != nullptr && nt >= 8) {
      u16* dst; unsigned tstride;
      if (mt < 128) { dst = vtx + (long)(mt >> 5) * 1024 * 8192 + (mt & 31) * 256; tstride = 8192; }
      else          { dst = vtc + (long)(mt - 128) * 1024 * 256; tstride = 256; }
#pragma unroll
      for (int i = 0; i < 2; ++i)
#pragma unroll
        for (int j = 0; j < 4; ++j)
#pragma unroll
          for (int rq = 0; rq < 4; ++rq) {
            const int row = wm * 64 + i * 32 + 8 * rq + 4 * (lane >> 5);
            const int hd = (nt - 8) * 256 + wn * 128 + j * 32 + (lane & 31);
            const unsigned v0 = f2bf(acc[i][j][4 * rq + 0]), v1 = f2bf(acc[i][j][4 * rq + 1]);
            const unsigned v2 = f2bf(acc[i][j][4 * rq + 2]), v3 = f2bf(acc[i][j][4 * rq + 3]);
            *reinterpret_cast<uint2*>(&dst[(unsigned)(hd * tstride + row)]) = make_uint2(v0 | (v1 << 16), v2 | (v3 << 16));
          }
    } else {
      char* wb = reinterpret_cast<char*>(smem) + wid * 17408;
#pragma unroll
      for (int i = 0; i < 2; ++i)
#pragma unroll
        for (int j = 0; j < 4; ++j)
#pragma unroll
          for (int r = 0; r < 16; ++r) {
            const int row = i * 32 + (r & 3) + 8 * (r >> 2) + 4 * (lane >> 5);
            const int col = j * 32 + (lane & 31);
            *reinterpret_cast<u16*>(wb + row * 272 + col * 2) = f2bf(acc[i][j][r] * sc);
          }
      asm volatile("s_waitcnt lgkmcnt(0)" ::: "memory");
#pragma unroll
      for (int q = 0; q < 16; ++q) {
        const int idx = q * 64 + lane, row = idx >> 4, c16 = idx & 15;
        const uint4 v = *reinterpret_cast<const uint4*>(wb + row * 272 + c16 * 16);
        *reinterpret_cast<uint4*>(&Cb[(unsigned)((wm * 64 + row) * ldc + wn * 128 + c16 * 8)]) = v;
      }
    }
    __syncthreads();
  }
}

__device__ __forceinline__ void gemm_swiglu_phase(const u16* A, const u16* Bt, u16* C, int Mt, u16* smem, u16* smv = nullptr) {
  if (smv != nullptr) {
    const int NtS = 44, nS = 8 * NtS;
    for (int t = VBID; t < nS; t += VGRID) {
      const int ms = t / NtS, ns = t - ms * NtS;
      const u16* Ab = A + (long)(N_X + ms * 128) * 1024;
      const u16* Bb = Bt + (long)ns * 128 * 1024;
      auto al = [=](int r, int k) { return ldg16(Ab + (unsigned)(r * 1024 + k)); };
      auto bl = [=](int r, int k) { return ldg16(Bb + (unsigned)(r * 1024 + k)); };
      f32x16 acc[2][2];
      gemm_tile<false>(al, bl, 1024, smv, acc);
      int tid_ = VTID;
      asm volatile("" : "+v"(tid_));
      const int lane = tid_ & 63, wid = tid_ >> 6, wm = wid >> 1, wn = wid & 1;
      u16* Cb = C + (long)(N_X + ms * 128) * 2816 + ns * 64;
#pragma unroll
      for (int i = 0; i < 2; ++i)
#pragma unroll
        for (int r = 0; r < 16; ++r) {
          const int row = wm * 64 + i * 32 + (r & 3) + 8 * (r >> 2) + 4 * (lane >> 5);
          const float g = acc[i][0][r], u = acc[i][1][r];
          Cb[(unsigned)(row * 2816 + wn * 32 + (lane & 31))] = f2bf(g * sigmoidf_(g) * u);
        }
    }
    __syncthreads();
    Mt = 128;
  }
  const int Nt = 22, nT = Mt * Nt;
  for (int t = blockIdx.x; t < nT; t += gridDim.x) {
    int mt, nt; tile_map256(t, Mt, Nt, mt, nt);
    const u16* Ab = A + (long)mt * 256 * 1024;
    const u16* Bb = Bt + (long)nt * 256 * 1024;
    f32x16 acc[2][4];
    gemm256_tile(Ab, 1024, Bb, 1024, 1024, reinterpret_cast<char*>(smem), acc);
    int tid_ = threadIdx.x;
    asm volatile("" : "+v"(tid_));
    const int lane = tid_ & 63, wid = tid_ >> 6, wm = wid >> 1, wn = wid & 1;
    u16* Cb = C + (long)mt * 256 * 2816 + nt * 128;
    char* wb = reinterpret_cast<char*>(smem) + wid * 9216;
#pragma unroll
    for (int i = 0; i < 2; ++i)
#pragma unroll
      for (int jp = 0; jp < 2; ++jp)
#pragma unroll
        for (int r = 0; r < 16; ++r) {
          const int row = i * 32 + (r & 3) + 8 * (r >> 2) + 4 * (lane >> 5);
          const int col = jp * 32 + (lane & 31);
          const float g = acc[i][2 * jp][r], u = acc[i][2 * jp + 1][r];
          *reinterpret_cast<u16*>(wb + row * 144 + col * 2) = f2bf(g * sigmoidf_(g) * u);
        }
    asm volatile("s_waitcnt lgkmcnt(0)" ::: "memory");
#pragma unroll
    for (int q = 0; q < 8; ++q) {
      const int idx = q * 64 + lane, row = idx >> 3, c16 = idx & 7;
      const uint4 v = *reinterpret_cast<const uint4*>(wb + row * 144 + c16 * 16);
      *reinterpret_cast<uint4*>(&Cb[(unsigned)((wm * 64 + row) * 2816 + wn * 64 + c16 * 8)]) = v;
    }
    __syncthreads();
  }
}

__device__ __forceinline__ void transpose_tile(const float* src, int ldn, int k0, int n0, u16* dst, int ldk, int mode, float* sm) {
  const int tid = VTID;
  const int cc = tid & 63, rr = tid >> 6;
#pragma unroll 4
  for (int i = 0; i < 16; ++i) {
    const int r = rr + 4 * i;
    sm[r * 65 + cc] = src[(long)(k0 + r) * ldn + n0 + cc];
  }
  __syncthreads();
#pragma unroll
  for (int i = 0; i < 2; ++i) {
    const int n = (tid >> 3) + 32 * i, kg = tid & 7;
    unsigned v[8];
#pragma unroll
    for (int j = 0; j < 8; ++j) v[j] = f2bf(sm[(kg * 8 + j) * 65 + n]);
    const int gn = n0 + n;
    int drow = gn;
    if (mode == 1) drow = (gn >> 5) * 64 + (gn & 31);
    else if (mode == 2) drow = (gn >> 5) * 64 + 32 + (gn & 31);
    *reinterpret_cast<uint4*>(&dst[(long)drow * ldk + k0 + kg * 8]) =
        make_uint4(v[0] | (v[1] << 16), v[2] | (v[3] << 16), v[4] | (v[5] << 16), v[6] | (v[7] << 16));
  }
  __syncthreads();
}

__device__ __forceinline__ void mod_gemv_item(const Params& P, int item, float* sm) {
  const int tid = VTID;
  const int l = item / 96, jg = item % 96;
  for (int idx = tid; idx < 5120; idx += VTHR) {
    const int m = idx >> 10, k = idx & 1023;
    const float v = (m < 4) ? P.c[m * 1024 + k] : P.c_ctx[k];
    sm[idx] = v / (1.f + __expf(-v));
  }
  __syncthreads();
  const int kq = tid >> 6, jj = tid & 63;
  float a0 = 0, a1 = 0, a2 = 0, a3 = 0, a4 = 0;
  const float* w = P.w_mod + ((long)l * 1024 + kq * 256) * 6144 + jg * 64 + jj;
  const float* s = sm + kq * 256;
#pragma unroll 8
  for (int k = 0; k < 256; ++k) {
    const float wv = w[(long)k * 6144];
    a0 += s[k] * wv; a1 += s[1024 + k] * wv; a2 += s[2048 + k] * wv; a3 += s[3072 + k] * wv; a4 += s[4096 + k] * wv;
  }
  float* red = sm + 5120;
  red[(kq * 5 + 0) * 64 + jj] = a0; red[(kq * 5 + 1) * 64 + jj] = a1; red[(kq * 5 + 2) * 64 + jj] = a2;
  red[(kq * 5 + 3) * 64 + jj] = a3; red[(kq * 5 + 4) * 64 + jj] = a4;
  __syncthreads();
  for (int idx = tid; idx < 320; idx += VTHR) {
    const int m = idx >> 6, j = idx & 63;
    const float v = red[(0 * 5 + m) * 64 + j] + red[(1 * 5 + m) * 64 + j] + red[(2 * 5 + m) * 64 + j] + red[(3 * 5 + m) * 64 + j];
    const int col = jg * 64 + j;
    P.mod[(long)(l * 5 + m) * 6144 + col] = v + P.b_mod[l * 6144 + col];
  }
  __syncthreads();
}

__device__ __forceinline__ void const_item(const Params& P, int item) {
  const int tid = VTID;
#pragma unroll 1
  for (int i = 0; i < 8; ++i) {
    const int off = tid + 256 * i;
    if (item < 1024) {
      const int e = item * 2048 + off;
      const int t2 = e >> 14, m = (e >> 7) & 127, k = e & 127;
      const int ro = m & 1, k1 = m >> 1, ri = k & 1, t1 = k >> 1;
      const int idx = (k1 * t1 * 128 + k1 * t2) & 8191;
      float sn, cs;
      sincospif((float)idx * (1.f / 4096.f), &sn, &cs);
      const float v = (ro == ri) ? cs : (ro == 0 ? sn : -sn);
      P.sbm[e] = f2bf(v * 0.125f);
    } else if (item < 1024 + 64) {
      const int e = (item - 1024) * 2048 + off;
      const int m = e >> 9, kk = e & 511, ri = kk & 1, t = kk >> 1;
      const int idx = (m * t) & 255;
      float sn, cs;
      sincospif((float)idx * (1.f / 128.f), &sn, &cs);
      P.sxm[e] = f2bf((ri == 0 ? cs : sn) * 0.0625f);
    } else if (item < 1024 + 128) {
      const int e = (item - 1088) * 2048 + off;
      const int ii = e & 63, j = (e >> 6) & 63, ai = (e >> 12) & 1, h = (e >> 13) & 7, d = e >> 16;
      const float* src = ai ? P.w_i : P.w_a;
      P.wg[e] = f2bf(src[((long)(d * 8 + h) * 64 + ii) * 64 + j] * -1.4426950408889634f);
    } else if (item < 1024 + 128 + 16) {
      const int e = (item - 1152) * 2048 + off;
      const int m = e >> 8, k = e & 255, ro = k >> 7, t2 = k & 127;
      const int idx = (m * t2) & 127;
      float sn, cs;
      sincospif((float)idx * (1.f / 64.f), &sn, &cs);
      P.scm[e] = f2bf((ro == 0 ? cs : sn) * 0.08838834764831845f);
    } else {
      const int e = (item - 1168) * 2048 + off;
      const int n = e >> 6, c = e & 63, ri = n >> 6, j = n & 63;
      const int idx = (j * c) & 63;
      float sn, cs;
      sincospif((float)idx * (1.f / 32.f), &sn, &cs);
      P.d64t[e] = f2bf((ri == 0 ? cs : -sn) * 0.125f);
    }
  }
}

__device__ __forceinline__ void prep_phase(const Params& P, float* sm) {
  const int NG = 192, NTR = 5888, NC = 1172;
  for (int it = VBID; it < NG; it += VGRID) mod_gemv_item(P, it, sm);
  for (int tt = VBID; tt < NTR; tt += VGRID) {
    int t = tt;
    const float* src; u16* dst; int ldn, ldk, mode = 0, kt, ntl;
    if (t < 384) { src = P.w_in_ab; dst = P.wt_in; ldn = 1536; ldk = 1024; kt = t / 24; ntl = t % 24; }
    else if (t < 640) { t -= 384; src = P.w_out_ab; dst = P.wt_outab; ldn = 1024; ldk = 1024; kt = t / 16; ntl = t % 16; }
    else if (t < 1408) { t -= 640; src = P.w_qkv; dst = P.wt_qkv; ldn = 3072; ldk = 1024; kt = t / 48; ntl = t % 48; }
    else if (t < 1664) { t -= 1408; src = P.w_out_na; dst = P.wt_outna; ldn = 1024; ldk = 1024; kt = t / 16; ntl = t % 16; }
    else if (t < 1664 + 2816) {
      t -= 1664;
      const int which = t / 704, tq = t % 704;
      const int l = which & 1, isup = which >> 1;
      src = (isup ? P.w_up : P.w_gate) + (long)l * 1024 * 2816;
      dst = P.wt_gu + (long)l * 5632 * 1024;
      ldn = 2816; ldk = 1024; mode = isup ? 2 : 1; kt = tq / 44; ntl = tq % 44;
    } else {
      t -= 1664 + 2816;
      const int l = t / 704, tq = t % 704;
      src = P.w_down + (long)l * 2816 * 1024;
      dst = P.wt_dn + (long)l * 1024 * 2816;
      ldn = 1024; ldk = 2816; kt = tq / 16; ntl = tq % 16;
    }
    transpose_tile(src, ldn, kt * 64, ntl * 64, dst, ldk, mode, sm);
  }
  for (int it = VBID; it < NC; it += VGRID) const_item(P, it);
}

__device__ __forceinline__ void row_phase(const Params& P, int glayer, int layer, int xsrc, bool hasY, int gate_idx, const float* gpost,
                          int xdst, bool doH, const float* gpre, int sh_idx, int nrows) {
  const int lane = threadIdx.x & 63, wid = threadIdx.x >> 6;
  const int stride = gridDim.x * 8;
  u16* resA = reinterpret_cast<u16*>(P.out);
  for (int rb = blockIdx.x * 8 + wid; rb < nrows; rb += 4 * stride) {
    uint4 xr[4][4];
    uint2 yy[4][4];
#pragma unroll
    for (int u = 0; u < 4; ++u) {
      const int R = rb + u * stride;
      if (R < nrows) {
        if (xsrc != 0 && R < N_X) {
          const u16* xs_ = ((xsrc == 1) ? resA : P.zf) + (long)R * 1024;
#pragma unroll
          for (int i = 0; i < 4; ++i) {
            const uint2 t2 = *reinterpret_cast<const uint2*>(xs_ + (i * 64 + lane) * 4);
            xr[u][i].x = t2.x; xr[u][i].y = t2.y;
          }
        } else {
          const float* xin_;
          if (xsrc == 0) xin_ = R < N_X ? P.x + (long)R * 1024 : P.ctx + (long)(R - N_X) * 1024;
          else           xin_ = P.xc + (long)(R - N_X) * 1024;
#pragma unroll
          for (int i = 0; i < 4; ++i) xr[u][i] = *reinterpret_cast<const uint4*>(xin_ + (i * 64 + lane) * 4);
        }
        if (hasY) {
          const u16* y_ = P.hy + (long)R * 1024;
#pragma unroll
          for (int i = 0; i < 4; ++i) yy[u][i] = *reinterpret_cast<const uint2*>(y_ + (i * 64 + lane) * 4);
        }
      }
    }
#pragma unroll
    for (int u = 0; u < 4; ++u) {
      const int row = rb + u * stride;
      if (row < nrows) {
        const int mi = row < N_X ? (row >> 13) : 4;
        const float* modp = P.mod + (long)(layer * 5 + mi) * 6144;
        const float* modg = P.mod + (long)(glayer * 5 + mi) * 6144;
        float4 xv[4];
        if (xsrc != 0 && row < N_X) {
#pragma unroll
          for (int i = 0; i < 4; ++i) {
            const uint4 raw = xr[u][i];
            xv[i].x = bf2f((u16)(raw.x & 0xffff)); xv[i].y = bf2f((u16)(raw.x >> 16));
            xv[i].z = bf2f((u16)(raw.y & 0xffff)); xv[i].w = bf2f((u16)(raw.y >> 16));
          }
        } else {
#pragma unroll
          for (int i = 0; i < 4; ++i) {
            xv[i].x = __uint_as_float(xr[u][i].x); xv[i].y = __uint_as_float(xr[u][i].y);
            xv[i].z = __uint_as_float(xr[u][i].z); xv[i].w = __uint_as_float(xr[u][i].w);
          }
        }
        if (hasY) {
          float4 yv[4];
          float ss = 0.f;
#pragma unroll
          for (int i = 0; i < 4; ++i) {
            const uint2 raw = yy[u][i];
            yv[i].x = bf2f((u16)(raw.x & 0xffff)); yv[i].y = bf2f((u16)(raw.x >> 16));
            yv[i].z = bf2f((u16)(raw.y & 0xffff)); yv[i].w = bf2f((u16)(raw.y >> 16));
            ss += yv[i].x * yv[i].x + yv[i].y * yv[i].y + yv[i].z * yv[i].z + yv[i].w * yv[i].w;
          }
          ss = wave_sum(ss);
          const float rstd = __builtin_amdgcn_rsqf(ss * (1.f / 1024.f) + EPSF);
#pragma unroll
          for (int i = 0; i < 4; ++i) {
            const int col = (i * 64 + lane) * 4;
            const float4 gt = *reinterpret_cast<const float4*>(modg + gate_idx * 1024 + col);
            const float4 gp = *reinterpret_cast<const float4*>(gpost + col);
            xv[i].x += gt.x * (yv[i].x * rstd * gp.x); xv[i].y += gt.y * (yv[i].y * rstd * gp.y);
            xv[i].z += gt.z * (yv[i].z * rstd * gp.z); xv[i].w += gt.w * (yv[i].w * rstd * gp.w);
          }
        }
        if (xdst == 3 || (xdst == 1 && row >= N_X)) {
          float* xout = (xdst == 3) ? P.out + (long)row * 1024 : P.xc + (long)(row - N_X) * 1024;
#pragma unroll
          for (int i = 0; i < 4; ++i) *reinterpret_cast<float4*>(xout + (i * 64 + lane) * 4) = xv[i];
        } else if (xdst != 0) {
          u16* xo = ((xdst == 1) ? resA : P.zf) + (long)row * 1024;
#pragma unroll
          for (int i = 0; i < 4; ++i) {
            const unsigned b0 = f2bf(xv[i].x), b1 = f2bf(xv[i].y), b2 = f2bf(xv[i].z), b3 = f2bf(xv[i].w);
            *reinterpret_cast<uint2*>(xo + (i * 64 + lane) * 4) = make_uint2(b0 | (b1 << 16), b2 | (b3 << 16));
          }
        }
        if (doH) {
          float ss = 0.f;
#pragma unroll
          for (int i = 0; i < 4; ++i) ss += xv[i].x * xv[i].x + xv[i].y * xv[i].y + xv[i].z * xv[i].z + xv[i].w * xv[i].w;
          ss = wave_sum(ss);
          const float rstd = __builtin_amdgcn_rsqf(ss * (1.f / 1024.f) + EPSF);
          u16* h = P.hy + (long)row * 1024;
#pragma unroll
          for (int i = 0; i < 4; ++i) {
            const int col = (i * 64 + lane) * 4;
            const float4 g = *reinterpret_cast<const float4*>(gpre + col);
            const float4 sh = *reinterpret_cast<const float4*>(modp + sh_idx * 1024 + col);
            const float4 sc = *reinterpret_cast<const float4*>(modp + (sh_idx + 1) * 1024 + col);
            const unsigned h0 = f2bf(xv[i].x * rstd * g.x * (1.f + sc.x) + sh.x);
            const unsigned h1 = f2bf(xv[i].y * rstd * g.y * (1.f + sc.y) + sh.y);
            const unsigned h2 = f2bf(xv[i].z * rstd * g.z * (1.f + sc.z) + sh.z);
            const unsigned h3 = f2bf(xv[i].w * rstd * g.w * (1.f + sc.w) + sh.w);
            *reinterpret_cast<uint2*>(h + col) = make_uint2(h0 | (h1 << 16), h2 | (h3 << 16));
          }
        }
      }
    }
  }
}

__device__ __forceinline__ void lru_tile(const Params& P, int chunk, int head, int pass, char* smem_raw) {
  u16* sm_uc = reinterpret_cast<u16*>(smem_raw);
  u16* sm_w = sm_uc + 128 * LDSS;
  float* sm_a = reinterpret_cast<float*>(sm_w + 128 * LDSS);
  float* sm_b = sm_a + 64 * 64;
  float2* sm_ph = reinterpret_cast<float2*>(sm_b + 64 * 64);
  float* sm_init = reinterpret_cast<float*>(sm_ph + 256);
  const int tid = VTID, lane = tid & 63, wid = tid >> 6;
  const int q = tid >> 6, ch = tid & 63;
  const int row0 = chunk * 128;
  int seq_lo, seq_hi;
  if (chunk < 256) { seq_lo = (chunk >> 6) << 13; seq_hi = seq_lo + 8192; }
  else { const int b = (chunk - 256) >> 1; seq_lo = N_X + b * 256; seq_hi = seq_lo + 256; }
  const int gch = head * 64 + ch;
  const float* hfbuf = reinterpret_cast<const float*>(P.hy);
  float* hfw = reinterpret_cast<float*>(P.hy);
  __syncthreads();
  {
    const float w0 = P.conv_w[gch], w1 = P.conv_w[512 + gch], w2 = P.conv_w[1024 + gch], w3 = P.conv_w[1536 + gch];
    const float cb = P.conv_b[gch];
    const u16* zu = P.zq + gch;
    const int r = row0 + q * 32;
    float uv[35];
#pragma unroll
    for (int i = 0; i < 35; ++i) {
      const int rr = r - 2 + i;
      uv[i] = (rr >= seq_lo && rr < seq_hi) ? bf2f(zu[(long)rr * 1536]) : 0.f;
    }
#pragma unroll
    for (int i = 0; i < 32; ++i) {
      const float v = cb + uv[i] * w0 + uv[i + 1] * w1 + uv[i + 2] * w2 + uv[i + 3] * w3;
      sm_uc[(q * 32 + i) * LDSS + ch] = f2bf(v);
    }
  }
  if (pass == 2 && tid < 128) {
    const int d = tid >> 6;
    float h = 0.f;
    const float2* S = P.summ + (long)d * 264 * 512 + gch;
    if (chunk < 256) {
      const int b = chunk >> 6, j = chunk & 63;
      if (d == 0) {
        float2 s = S[(long)(256 + 2 * b) * 512]; h = s.x * h + s.y;
        s = S[(long)(256 + 2 * b + 1) * 512]; h = s.x * h + s.y;
        int i = 0;
        for (; i + 8 <= j; i += 8) {
          float2 sv[8];
#pragma unroll
          for (int u = 0; u < 8; ++u) sv[u] = S[(long)(b * 64 + i + u) * 512];
#pragma unroll
          for (int u = 0; u < 8; ++u) h = sv[u].x * h + sv[u].y;
        }
        for (; i < j; ++i) { s = S[(long)(b * 64 + i) * 512]; h = s.x * h + s.y; }
      } else {
        float2 s = S[(long)(256 + 2 * b + 1) * 512]; h = s.x * h + s.y;
        s = S[(long)(256 + 2 * b) * 512]; h = s.x * h + s.y;
        int i = 63;
        for (; i - 8 >= j; i -= 8) {
          float2 sv[8];
#pragma unroll
          for (int u = 0; u < 8; ++u) sv[u] = S[(long)(b * 64 + i - u) * 512];
#pragma unroll
          for (int u = 0; u < 8; ++u) h = sv[u].x * h + sv[u].y;
        }
        for (; i > j; --i) { s = S[(long)(b * 64 + i) * 512]; h = s.x * h + s.y; }
      }
    } else {
      const int b = (chunk - 256) >> 1, j = (chunk - 256) & 1;
      if (d == 0) { if (j == 1) { const float2 s = S[(long)(256 + 2 * b) * 512]; h = s.y; } }
      else        { if (j == 0) { const float2 s = S[(long)(256 + 2 * b + 1) * 512]; h = s.y; } }
    }
    sm_init[d * 64 + ch] = h;
  }
  for (int d = 0; d < 2; ++d) {
    __syncthreads();
#pragma unroll
    for (int i = 0; i < 4; ++i) {
      const int idx = tid + 256 * i, rowi = idx >> 3, kg = idx & 7;
      *reinterpret_cast<uint4*>(&sm_w[rowi * LDSS + kg * 8]) = ldg16(P.wg + ((long)(d * 8 + head) * 128 + rowi) * 64 + kg * 8);
    }
    float ba[4], bi[4], c8[4];
#pragma unroll
    for (int tc = 0; tc < 4; ++tc) {
      const int cidx = d * 512 + head * 64 + 16 * tc + (lane & 15);
      ba[tc] = P.b_a[cidx] * -1.4426950408889634f; bi[tc] = P.b_i[cidx] * -1.4426950408889634f;
      const float nl = -P.lam[cidx];
      const float e_ = __expf(nl);
      const float sp = (nl > 20.f) ? nl
                     : (e_ < 0.03f ? e_ * (1.f - e_ * (0.5f - e_ * (0.33333334f - 0.25f * e_))) : __logf(1.f + e_));
      c8[tc] = 8.f * 1.4426950408889634f * sp;
    }
    __syncthreads();
    float cA = 1.f, cB = (pass == 2) ? sm_init[d * 64 + ch] : 0.f;
    for (int sbi = 0; sbi < 2; ++sbi) {
      const int sb = (d == 0) ? sbi : 1 - sbi;
      f32x4 acc[8];
#pragma unroll
      for (int t = 0; t < 8; ++t) acc[t] = f32x4{0.f, 0.f, 0.f, 0.f};
#pragma unroll
      for (int s = 0; s < 2; ++s) {
        const bf16x8 af = *reinterpret_cast<const bf16x8*>(&sm_uc[(sb * 64 + wid * 16 + (lane & 15)) * LDSS + s * 32 + (lane >> 4) * 8]);
#pragma unroll
        for (int t = 0; t < 8; ++t) {
          const bf16x8 bfr = *reinterpret_cast<const bf16x8*>(&sm_w[(t * 16 + (lane & 15)) * LDSS + s * 32 + (lane >> 4) * 8]);
          acc[t] = __builtin_amdgcn_mfma_f32_16x16x32_bf16(af, bfr, acc[t], 0, 0, 0);
        }
      }
#pragma unroll
      for (int tc = 0; tc < 4; ++tc)
#pragma unroll
        for (int reg = 0; reg < 4; ++reg) {
          const int tl = wid * 16 + (lane >> 4) * 4 + reg;
          const int c = 16 * tc + (lane & 15);
          const float r = __builtin_amdgcn_rcpf(1.f + __builtin_amdgcn_exp2f(acc[tc][reg] + ba[tc]));
          const float ii = __builtin_amdgcn_rcpf(1.f + __builtin_amdgcn_exp2f(acc[tc + 4][reg] + bi[tc]));
          const float la = -c8[tc] * r;
          const float a = __builtin_amdgcn_exp2f(la);
          const float ucv = bf2f(sm_uc[(sb * 64 + tl) * LDSS + c]);
          const float bt = __builtin_amdgcn_sqrtf(fmaxf(1.f - a * a, 0.f)) * (ii * ucv);
          sm_a[tl * 64 + c] = a;
          sm_b[tl * 64 + c] = bt;
        }
      __syncthreads();
      const int pos = (d == 0) ? q : 3 - q;
      {
        float Pp = 1.f, H = 0.f;
#pragma unroll 4
        for (int i = 0; i < 16; ++i) {
          const int tl = (d == 0) ? (q * 16 + i) : (q * 16 + 15 - i);
          const float a = sm_a[tl * 64 + ch], b = sm_b[tl * 64 + ch];
          H = a * H + b; Pp *= a;
        }
        sm_ph[pos * 64 + ch] = make_float2(Pp, H);
      }
      __syncthreads();
      const float2 p0 = sm_ph[ch], p1 = sm_ph[64 + ch], p2 = sm_ph[128 + ch], p3 = sm_ph[192 + ch];
      if (pass == 2) {
        float hin = cB;
        if (pos > 0) hin = p0.x * hin + p0.y;
        if (pos > 1) hin = p1.x * hin + p1.y;
        if (pos > 2) hin = p2.x * hin + p2.y;
        float h = hin;
        float hfp[16], gp[16];
        if (d == 1) {
#pragma unroll
          for (int i = 0; i < 16; ++i) {
            const long rowp = row0 + sb * 64 + q * 16 + 15 - i;
            hfp[i] = hfbuf[rowp * 512 + gch];
            gp[i] = bf2f(P.zq[rowp * 1536 + 512 + gch]);
          }
        }
#pragma unroll
        for (int i = 0; i < 16; ++i) {
          const int tl = (d == 0) ? (q * 16 + i) : (q * 16 + 15 - i);
          const float a = sm_a[tl * 64 + ch], b = sm_b[tl * 64 + ch];
          h = a * h + b;
          const long row = row0 + sb * 64 + tl;
          if (d == 0) {
            hfw[row * 512 + gch] = h;
          } else {
            const float hfv = hfp[i];
            const float g = gp[i];
            const float tz = 0.7978845608028654f * (g + 0.044715f * g * g * g);
            const float th = 1.f - 2.f * __builtin_amdgcn_rcpf(1.f + __expf(2.f * tz));
            const float ge = 0.5f * g * (1.f + th);
            P.cat[row * 1024 + gch] = f2bf((hfv + h) * ge);
          }
        }
      }
      cB = p0.x * cB + p0.y; cA *= p0.x;
      cB = p1.x * cB + p1.y; cA *= p1.x;
      cB = p2.x * cB + p2.y; cA *= p2.x;
      cB = p3.x * cB + p3.y; cA *= p3.x;
      __syncthreads();
    }
    if (pass == 1 && q == 0) P.summ[((long)d * 264 + chunk) * 512 + gch] = make_float2(cA, cB);
  }
}

__device__ __forceinline__ void attn_phase(const Params& P, char* smem_raw) {
  u16* sm_k = reinterpret_cast<u16*>(smem_raw);
  u16* sm_vt = sm_k + 128 * LDSS;
  u16* sm_p = sm_vt + 64 * 136;
  float* sm_rpb = reinterpret_cast<float*>(sm_p + 4 * 16 * 136);
  const int tid = VTID, lane = tid & 63, wid = tid >> 6;
  const u16* QKV = P.zq;
  const u16* VTX = P.zf;
  const u16* VTC = reinterpret_cast<const u16*>(P.summ);
  uint4 kreg[4], vreg[4];
  bf16x8 qn[2];
#define ATT_ISSUE(TT, CK)                                                                         \
  {                                                                                               \
    const int h_ = (TT) & 15, r_ = ((TT) >> 4) & 127, b_ = (TT) >> 11;                            \
    const int rs_ = min(max(r_ - 4, 0), 120);                                                     \
    const long krow0_ = ((CK) < 4) ? ((long)b_ * 8192 + rs_ * 64 + (CK) * 128)                    \
                                   : ((long)N_X + b_ * 256 + ((CK) - 4) * 128);                   \
    const u16* ksrc_ = QKV + krow0_ * 3072 + 1024 + h_ * 64;                                      \
    const u16* vsrc_ = ((CK) < 4) ? (VTX + ((long)(b_ * 16 + h_) * 64) * 8192 + rs_ * 64 + (CK) * 128) \
                                  : (VTC + ((long)(b_ * 16 + h_) * 64) * 256 + ((CK) - 4) * 128); \
    const unsigned vstride_ = ((CK) < 4) ? 8192u : 256u;                                          \
    _Pragma("unroll") for (int i = 0; i < 4; ++i) {                                               \
      const int idx = tid + 256 * i;                                                              \
      kreg[i] = ldg16(ksrc_ + (unsigned)((idx >> 3) * 3072 + (idx & 7) * 8));                     \
      vreg[i] = ldg16(vsrc_ + (unsigned)((idx >> 4) * vstride_ + (idx & 15) * 8));                \
    }                                                                                             \
  }
#define ATT_QLOAD(TT)                                                                             \
  {                                                                                               \
    const int h_ = (TT) & 15, r_ = ((TT) >> 4) & 127, b_ = (TT) >> 11;                            \
    const long qrow_ = (long)b_ * 8192 + r_ * 64 + wid * 16 + (lane & 15);                        \
    _Pragma("unroll") for (int s = 0; s < 2; ++s)                                                 \
      qn[s] = *reinterpret_cast<const bf16x8*>(QKV + qrow_ * 3072 + h_ * 64 + s * 32 + (lane >> 4) * 8); \
  }
  int dco[4][4];
#pragma unroll
  for (int reg = 0; reg < 4; ++reg) {
    const int c = wid * 16 + (lane >> 4) * 4 + reg;
    const int cs = min(max(c - 8, 0), 48);
#pragma unroll
    for (int q4 = 0; q4 < 4; ++q4) {
      const int kc = q4 * 16 + (lane & 15);
      dco[reg][q4] = (kc >= cs && kc < cs + 16) ? (kc - c + 15) : 465;
    }
  }
  int t = VBID;
  __syncthreads();
  if (t < 8192) {
    const int h0 = t & 15;
    for (int idx = tid; idx < 930; idx += VTHR) sm_rpb[idx] = (idx < 465) ? P.rpb[h0 * 465 + idx] * 1.4426950408889634f : -1e30f;
    ATT_ISSUE(t, 0)
    ATT_QLOAD(t)
  }
  for (; t < 8192; t += VGRID) {
    const int h = t & 15, r = (t >> 4) & 127, b = t >> 11;
    const int rs = min(max(r - 4, 0), 120);
    bf16x8 qf[2];
    qf[0] = qn[0]; qf[1] = qn[1];
    f32x4 o[4];
#pragma unroll
    for (int td = 0; td < 4; ++td) o[td] = f32x4{0.f, 0.f, 0.f, 0.f};
    float mrow[4], lrow[4];
#pragma unroll
    for (int reg = 0; reg < 4; ++reg) { mrow[reg] = -1e30f; lrow[reg] = 0.f; }
    for (int ck = 0; ck < 6; ++ck) {
      int lane_c = lane;
      asm volatile("" : "+v"(lane_c));
      __syncthreads();
#pragma unroll
      for (int i = 0; i < 4; ++i) {
        const int idx = tid + 256 * i;
        *reinterpret_cast<uint4*>(&sm_k[(idx >> 3) * LDSS + (idx & 7) * 8]) = kreg[i];
        *reinterpret_cast<uint4*>(&sm_vt[(idx >> 4) * 136 + (idx & 15) * 8]) = vreg[i];
      }
      __syncthreads();
      f32x4 sacc[8];
#pragma unroll
      for (int t8 = 0; t8 < 8; ++t8) sacc[t8] = f32x4{0.f, 0.f, 0.f, 0.f};
#pragma unroll
      for (int s = 0; s < 2; ++s)
#pragma unroll
        for (int t8 = 0; t8 < 8; ++t8) {
          const bf16x8 kf = *reinterpret_cast<const bf16x8*>(&sm_k[(t8 * 16 + (lane_c & 15)) * LDSS + s * 32 + (lane_c >> 4) * 8]);
          sacc[t8] = __builtin_amdgcn_mfma_f32_16x16x32_bf16(qf[s], kf, sacc[t8], 0, 0, 0);
        }
      if (ck < 5) {
        ATT_ISSUE(t, ck + 1)
      } else if (t + VGRID < 8192) {
        ATT_ISSUE(t + VGRID, 0)
        ATT_QLOAD(t + VGRID)
      }
      if (ck < 4) {
        const float* rb0 = sm_rpb + (rs + ck * 2 - r + 7) * 31;
#pragma unroll
        for (int t8 = 0; t8 < 8; ++t8)
#pragma unroll
          for (int reg = 0; reg < 4; ++reg)
            sacc[t8][reg] += rb0[(t8 >> 2) * 31 + dco[reg][t8 & 3]];
      }
#pragma unroll
      for (int reg = 0; reg < 4; ++reg) {
        float mx = sacc[0][reg];
#pragma unroll
        for (int t8 = 1; t8 < 8; ++t8) mx = fmaxf(mx, sacc[t8][reg]);
        mx = row16_max(mx);
        const float mnew = fmaxf(mrow[reg], mx);
        const float alpha = __builtin_amdgcn_exp2f(mrow[reg] - mnew);
        mrow[reg] = mnew;
        float rsum = 0.f;
#pragma unroll
        for (int t8 = 0; t8 < 8; ++t8) {
          const float p = __builtin_amdgcn_exp2f(sacc[t8][reg] - mnew);
          rsum += p;
          sm_p[(wid * 16 + (lane_c >> 4) * 4 + reg) * 136 + t8 * 16 + (lane_c & 15)] = f2bf(p);
        }
        rsum = row16_sum(rsum);
        lrow[reg] = lrow[reg] * alpha + rsum;
#pragma unroll
        for (int td = 0; td < 4; ++td) o[td][reg] *= alpha;
      }
      asm volatile("s_waitcnt lgkmcnt(0)" ::: "memory");
#pragma unroll
      for (int s4 = 0; s4 < 4; ++s4) {
        const bf16x8 pf = *reinterpret_cast<const bf16x8*>(&sm_p[(wid * 16 + (lane_c & 15)) * 136 + s4 * 32 + (lane_c >> 4) * 8]);
#pragma unroll
        for (int td = 0; td < 4; ++td) {
          const bf16x8 vf = *reinterpret_cast<const bf16x8*>(&sm_vt[(td * 16 + (lane_c & 15)) * 136 + s4 * 32 + (lane_c >> 4) * 8]);
          o[td] = __builtin_amdgcn_mfma_f32_16x16x32_bf16(pf, vf, o[td], 0, 0, 0);
        }
      }
    }
    u16* Ob = P.cat + ((long)b * 8192 + r * 64) * 1024 + h * 64;
#pragma unroll
    for (int td = 0; td < 4; ++td)
#pragma unroll
      for (int reg = 0; reg < 4; ++reg) {
        const int rowl = wid * 16 + (lane >> 4) * 4 + reg;
        Ob[(unsigned)(rowl * 1024 + td * 16 + (lane & 15))] = f2bf(o[td][reg] * __builtin_amdgcn_rcpf(lrow[reg]));
      }
  }
#undef ATT_ISSUE
#undef ATT_QLOAD
}

__device__ __forceinline__ void fourier_stepA_tile(const Params& P, int t, u16* smem) {
  const int mt = t >> 3, grp = t & 7;
  const u16* Ab = P.zq + (long)mt * 128 * 1536 + 1024 + grp * 64;
  const u16* Bb = P.d64t;
  auto al = [=](int r, int k) { return ldg16(Ab + (unsigned)(r * 1536 + k)); };
  auto bl = [=](int r, int k) { return ldg16(Bb + r * 64 + k); };
  f32x16 acc[2][2];
  gemm_tile<false>(al, bl, 64, smem, acc);
  u16* G = P.zq + (long)N_TOK * 1536 + (long)mt * 128 * 1024 + grp * 64;
  ACC_FOREACH({ G[(unsigned)(row * 1024 + (col >> 6) * 512 + (col & 63))] = f2bf(v); })
}
__device__ __forceinline__ void nn_phase(const Params& P, int set, u16* smem) {
  const int nT = (set == 0) ? 2080 : 1024;
  for (int t = VBID; t < nT; t += VGRID) {
    const u16 *Ab, *Bb; u16* Cb; unsigned lda, s1, s2, e1, e2; int K;
    const u16* G = P.zq + (long)N_TOK * 1536;
    const int nt = t & 3;
    if (set == 0 && t < 2048) {
      const int bt = t >> 2, t2 = bt & 127, b = bt >> 7;
      Ab = P.sbm + (long)t2 * 128 * 128; lda = 128; K = 128;
      Bb = G + ((long)b * 8192 + t2) * 1024 + nt * 128; s1 = 512; s2 = 128 * 1024;
      Cb = P.zf + (long)b * 64 * 256 * 512 + (long)t2 * 512 + nt * 128; e1 = 128 * 512; e2 = 256 * 512;
    } else if (set == 0) {
      const int tt = t - 2048, mt = (tt >> 2) & 1, b = tt >> 3;
      Ab = P.sxm + (long)mt * 128 * 512; lda = 512; K = 512;
      Bb = G + ((long)N_X + b * 256) * 1024 + nt * 128; s1 = 512; s2 = 1024;
      Cb = P.cat + ((long)N_X + b * 256 + mt * 128) * 1024 + 512 + nt * 128; e1 = 1024; e2 = 2048;
    } else {
      const int bk = t >> 2, k1 = bk & 63, b = bk >> 6;
      Ab = P.scm; lda = 256; K = 256;
      Bb = P.zf + ((long)b * 64 + k1) * 256 * 512 + nt * 128; s1 = 512; s2 = 1024;
      Cb = P.cat + ((long)b * 8192 + k1) * 1024 + 512 + nt * 128; e1 = 64 * 1024; e2 = 128 * 1024;
    }
    auto al = [=](int r, int k) { return ldg16(Ab + (unsigned)(r * lda + k)); };
    auto bl = [=](int n, int k) { return gather8p(Bb, (unsigned)((k >> 1) * s2 + n), s1, s2); };
    f32x16 acc[2][2];
    gemm_tile_nn<true>(al, bl, K, smem, acc);
    ACC_FOREACH({ Cb[(unsigned)((row >> 1) * e2 + (row & 1) * e1 + col)] = f2bf(v); })
  }
}

#define XB_TMO      128
#define XB_XCNT(j)  (256  + 64 * (j))
#define XB_XSUB(j)  (1280 + 64 * (j))
#define XB_XGEN(j)  (2304 + 64 * (j))
#define XB_TOP      3328
#define XB_TOPGEN   3392
#define XCD_BAR_WORDS 3456
#define XB_SPIN_CAP (1u << 18)
#define LAS __attribute__((address_space(3)))

__device__ __forceinline__ unsigned xb_ld(unsigned* p)              { return __hip_atomic_load(p, __ATOMIC_RELAXED, __HIP_MEMORY_SCOPE_AGENT); }
__device__ __forceinline__ unsigned xb_add(unsigned* p, unsigned v) { return __hip_atomic_fetch_add(p, v, __ATOMIC_RELAXED, __HIP_MEMORY_SCOPE_AGENT); }
__device__ __forceinline__ unsigned xb_xcc_id() { return (unsigned)__builtin_amdgcn_s_getreg((3 << 11) | 20) & 0xFu; }
#define XB_SPIN(cond, bar) do { unsigned _sp = 0; while (cond) { __builtin_amdgcn_s_sleep(1); \
    if ((++_sp & 255u) == 0u) { if (xb_ld(&(bar)[XB_TMO])) break; if (_sp > XB_SPIN_CAP) { atomicAdd(&(bar)[XB_TMO], 1u); break; } } } } while (0)

struct XcdBarrier {
    unsigned* bar; unsigned x;
    volatile LAS unsigned* st;
};

__device__ __forceinline__ XcdBarrier xcd_barrier_post(unsigned* bar, volatile LAS unsigned* st) {
    XcdBarrier b; b.bar = bar; b.x = xb_xcc_id(); b.st = st;
    if (threadIdx.x == 0) (void)xb_add(&bar[XB_XCNT(b.x)], 1u);
    return b;
}
__device__ __forceinline__ void xcd_barrier_complete(unsigned* bar, unsigned x, unsigned& nloc, unsigned& nx) {
    const unsigned G = gridDim.x * gridDim.y * gridDim.z;
    unsigned sum, cnt, mine, sp = 0u;
    for (;;) {
        sum = 0u; cnt = 0u; mine = 0u;
#pragma unroll
        for (unsigned j = 0; j < 16; ++j) { const unsigned c = xb_ld(&bar[XB_XCNT(j)]); sum += c; cnt += (c > 0u) ? 1u : 0u; mine = (j == x) ? c : mine; }
        if (sum == G) break;
        __builtin_amdgcn_s_sleep(1);
        if ((++sp & 255u) == 0u) { if (xb_ld(&bar[XB_TMO])) break; if (sp > XB_SPIN_CAP) { atomicAdd(&bar[XB_TMO], 1u); break; } }
    }
    nloc = mine > 0u ? mine : 1u; nx = cnt > 0u ? cnt : 1u;
}

__device__ __forceinline__ void xcd_barrier(const XcdBarrier& b) {
    asm volatile("s_waitcnt vmcnt(0)" ::: "memory");
    __syncthreads();
    if (threadIdx.x == 0) {
        unsigned* bar = b.bar;
        __builtin_amdgcn_s_waitcnt(0);
        unsigned nloc = b.st[0], nx = b.st[1];
        if (nloc == 0u) { xcd_barrier_complete(bar, b.x, nloc, nx); b.st[0] = nloc; b.st[1] = nx; }
        const unsigned old = xb_add(&bar[XB_XSUB(b.x)], 1u);
        const unsigned gen = old / nloc;
        if (old + 1u == (gen + 1u) * nloc) {
            __builtin_amdgcn_fence(__ATOMIC_RELEASE, "agent");
            asm volatile("s_waitcnt vmcnt(0)" ::: "memory");
            const unsigned og = xb_add(&bar[XB_TOP], 1u);
            const unsigned tg = og / nx;
            if (og + 1u == (tg + 1u) * nx) xb_add(&bar[XB_TOPGEN], 1u);
            else XB_SPIN(xb_ld(&bar[XB_TOPGEN]) == tg, bar);
            __builtin_amdgcn_fence(__ATOMIC_ACQUIRE, "agent");
            xb_add(&bar[XB_XGEN(b.x)], 1u);
            asm volatile("s_waitcnt vmcnt(0)" ::: "memory");
        } else {
            XB_SPIN(xb_ld(&bar[XB_XGEN(b.x)]) == gen, bar);
            __builtin_amdgcn_fence(__ATOMIC_ACQUIRE, "agent");
            asm volatile("s_waitcnt vmcnt(0)" ::: "memory");
        }
    }
    __syncthreads();
}


#define NPHASE 18
__device__ __forceinline__ void run_phase(const Params& P, const int ph, char* smem_raw) {
  u16* smem = reinterpret_cast<u16*>(smem_raw);
  int vb_ = threadIdx.x >> 8;
  asm volatile("" : "+v"(vb_));
  char* smv_raw = smem_raw + vb_ * SMEM_V;
  u16* smv = reinterpret_cast<u16*>(smv_raw);
#ifdef ONLY_PHASE
  if (ph != ONLY_PHASE) return;
#endif
  switch (ph) {
    case 0: prep_phase(P, reinterpret_cast<float*>(smv_raw)); break;
    case 1: row_phase(P, 0, 0, 0, false, 0, nullptr, 0, true, P.g_pre_mix, 0, N_TOK); break;
    case 2: gemm_nt_phase(P.hy, 1024, P.wt_in, 1024, P.zq, 1536, 132, 6, 1024, 0, 1.f, smem, nullptr, nullptr, smv); break;
    case 3:
      for (int t = VBID; t < 2112; t += VGRID) lru_tile(P, t >> 3, t & 7, 1, smv_raw);
      for (int t = VBID; t < 2112; t += VGRID) fourier_stepA_tile(P, t, smv);
      break;
    case 4:
      for (int t = VBID; t < 2112; t += VGRID) lru_tile(P, t >> 3, t & 7, 2, smv_raw);
      nn_phase(P, 0, smv);
      break;
    case 5: nn_phase(P, 1, smv); break;
    case 6: gemm_nt_phase(P.cat, 1024, P.wt_outab, 1024, P.hy, 1024, 132, 4, 1024, 0, 1.f, smem, nullptr, nullptr, smv); break;
    case 7: row_phase(P, 0, 0, 0, true, 2, P.g_post_mix, 1, true, P.g_pre_ffn, 3, N_TOK); break;
    case 8: gemm_swiglu_phase(P.hy, P.wt_gu, P.zq, 132, smem, smv); break;
    case 9: gemm_nt_phase(P.zq, 2816, P.wt_dn, 2816, P.hy, 1024, 132, 4, 2816, 0, 1.f, smem, nullptr, nullptr, smv); break;
    case 10: row_phase(P, 0, 1, 1, true, 5, P.g_post_ffn, 1, true, P.g_pre_mix + 1024, 0, N_TOK); break;
    case 11: gemm_nt_phase(P.hy, 1024, P.wt_qkv, 1024, P.zq, 3072, 132, 12, 1024, 1024, 0.125f * 1.4426950408889634f, smem, P.zf, reinterpret_cast<u16*>(P.summ), smv); break;
    case 12:
      attn_phase(P, smv_raw);
      break;
    case 13: gemm_nt_phase(P.cat, 1024, P.wt_outna, 1024, P.hy, 1024, 128, 4, 1024, 0, 1.f, smem); break;
    case 14: row_phase(P, 1, 1, 1, true, 2, P.g_post_mix + 1024, 2, true, P.g_pre_ffn + 1024, 3, N_X); break;
    case 15: gemm_swiglu_phase(P.hy, P.wt_gu + (long)5632 * 1024, P.zq, 128, smem); break;
    case 16: gemm_nt_phase(P.zq, 2816, P.wt_dn + (long)1024 * 2816, 2816, P.hy, 1024, 128, 4, 2816, 0, 1.f, smem); break;
    case 17: row_phase(P, 1, 1, 2, true, 5, P.g_post_ffn + 1024, 3, false, nullptr, 0, N_X); break;
    default: break;
  }
}

__global__ void __launch_bounds__(NTHR) mega_kernel(Params P, int lo, int hi) {
  extern __shared__ __attribute__((aligned(16))) char smem_raw[];
  __shared__ uint4 xb_words;
  cg::grid_group grid = cg::this_grid();
  if (threadIdx.x == 0) xb_words = make_uint4(0u, 0u, 0u, 0u);
  if (blockIdx.x == 0) for (int i = threadIdx.x; i < XCD_BAR_WORDS; i += NTHR) P.bar[i] = 0u;
  __syncthreads();
  if (lo <= 0 && 0 < hi) { run_phase(P, 0, smem_raw); if (1 < hi) { grid.sync(); (void)xcd_barrier_post(P.bar, (volatile LAS unsigned*)&xb_words); } }
#ifndef DUPMASK
#define DUPMASK 0
#endif
#define RUN_PH(n) if (lo <= (n) && (n) < hi) { run_phase(P, (n), smem_raw); if ((DUPMASK >> (n)) & 1) run_phase(P, (n), smem_raw); if ((n) + 1 < hi) { XcdBarrier xb_; xb_.bar = P.bar; xb_.x = xb_xcc_id(); xb_.st = (volatile LAS unsigned*)&xb_words; xcd_barrier(xb_); } }
  RUN_PH(1) RUN_PH(2) RUN_PH(3) RUN_PH(4) RUN_PH(5) RUN_PH(6) RUN_PH(7) RUN_PH(8)
  RUN_PH(9) RUN_PH(10) RUN_PH(11) RUN_PH(12) RUN_PH(13) RUN_PH(14) RUN_PH(15) RUN_PH(16) RUN_PH(17)
}

extern "C" void kernel_launch(void* const* d_in, const int* in_sizes, int n_in, void* d_out, int out_size,
                              void* d_ws, size_t ws_size, hipStream_t stream) {
  (void)in_sizes; (void)n_in; (void)out_size; (void)ws_size;
  Params p{};
  const float* const* in = reinterpret_cast<const float* const*>(d_in);
  p.x = in[0]; p.c = in[1]; p.ctx = in[2]; p.c_ctx = in[3]; p.w_mod = in[4]; p.b_mod = in[5];
  p.g_pre_mix = in[6]; p.g_post_mix = in[7]; p.g_pre_ffn = in[8]; p.g_post_ffn = in[9];
  p.w_gate = in[10]; p.w_up = in[11]; p.w_down = in[12]; p.w_in_ab = in[13]; p.conv_w = in[14]; p.conv_b = in[15];
  p.w_a = in[16]; p.b_a = in[17]; p.w_i = in[18]; p.b_i = in[19]; p.lam = in[20]; p.w_out_ab = in[21];
  p.w_qkv = in[22]; p.rpb = in[23]; p.w_out_na = in[24];
  p.out = reinterpret_cast<float*>(d_out);
  char* ws = reinterpret_cast<char*>(d_ws);
  size_t off = 0;
  auto take = [&](size_t bytes) { char* r = ws + off; off += (bytes + 255) & ~(size_t)255; return r; };
  p.wt_in = (u16*)take((size_t)1536 * 1024 * 2);
  p.wt_outab = (u16*)take((size_t)1024 * 1024 * 2);
  p.wt_qkv = (u16*)take((size_t)3072 * 1024 * 2);
  p.wt_outna = (u16*)take((size_t)1024 * 1024 * 2);
  p.wt_gu = (u16*)take((size_t)2 * 5632 * 1024 * 2);
  p.wt_dn = (u16*)take((size_t)2 * 1024 * 2816 * 2);
  p.mod = (float*)take((size_t)2 * 5 * 6144 * 4);
  p.d64t = (u16*)take((size_t)128 * 64 * 2);
  p.sbm = (u16*)take((size_t)128 * 128 * 128 * 2);
  p.scm = (u16*)take((size_t)128 * 256 * 2);
  p.sxm = (u16*)take((size_t)256 * 512 * 2);
  p.wg = (u16*)take((size_t)2 * 8 * 2 * 64 * 64 * 2);
  p.summ = (float2*)take((size_t)2 * 264 * 512 * 8);
  p.xc = (float*)take((size_t)1024 * 1024 * 4);
  p.hy = (u16*)take((size_t)N_TOK * 1024 * 2);
  p.zq = (u16*)take((size_t)N_TOK * 3072 * 2);
  p.zf = (u16*)take((size_t)4 * 64 * 256 * 512 * 2);
  p.cat = (u16*)take((size_t)N_TOK * 1024 * 2);
  p.bar = (unsigned*)take((size_t)XCD_BAR_WORDS * 4);

  static int grid_blocks = 0;
  if (!grid_blocks) {
    int dev = 0, cus = 0, per_cu = 0;
    hipGetDevice(&dev);
    hipDeviceGetAttribute(&cus, hipDeviceAttributeMultiprocessorCount, dev);
    hipFuncSetAttribute(reinterpret_cast<const void*>(mega_kernel), hipFuncAttributeMaxDynamicSharedMemorySize, SMEM_BYTES);
    hipOccupancyMaxActiveBlocksPerMultiprocessor(&per_cu, mega_kernel, NTHR, SMEM_BYTES);
    if (per_cu < 1) per_cu = 1;
    if (per_cu > 1) per_cu = 1;
    grid_blocks = cus * per_cu;
  }
#if ONE_LAUNCH
  int lo = 0, hi = NPHASE;
  void* args[] = {&p, &lo, &hi};
  hipError_t e = hipLaunchCooperativeKernel(reinterpret_cast<const void*>(mega_kernel), dim3(grid_blocks), dim3(NTHR), args,
                                            SMEM_BYTES, stream);
  if (e != hipSuccess) fprintf(stderr, "cooperative launch failed: %s (grid %d)\n", hipGetErrorString(e), grid_blocks);
#else
  for (int ph = 0; ph < NPHASE; ++ph)
    hipLaunchKernelGGL(mega_kernel, dim3(grid_blocks), dim3(NTHR), SMEM_BYTES, stream, p, ph, ph + 1);
#endif
}
```
